# Optimizing an MI355X kernel written in HIP

```python
import jax, jax.numpy as jnp
from jax import lax
import numpy as np

D_MODEL = 1024
BATCH = 32
SEQ = 256
DEPTH = 2
DEC_BATCH = 4
DEC_SEQ = 1024
PAST_LEN = 512

GRID_W = 64
HEAD_DIM = 64
FOURIER_W = D_MODEL // 4
FOURIER_GROUPS = FOURIER_W // HEAD_DIM
HGRN_W = D_MODEL // 4
HGRN_HEADS = HGRN_W // HEAD_DIM
ATTN_W = D_MODEL // 2
ATTN_HEADS = ATTN_W // HEAD_DIM
ATTN_KV_HEADS = 2
ATTN_GROUP = ATTN_HEADS // ATTN_KV_HEADS
KV_W = ATTN_KV_HEADS * HEAD_DIM
MIX_W = FOURIER_W + HGRN_W + ATTN_W
SPLIT_SIZES = (FOURIER_W, HGRN_W, HGRN_W, HGRN_W, HGRN_W, HGRN_W, ATTN_W, KV_W, KV_W)
IN_W = sum(SPLIT_SIZES)
WINDOW = 128
BLOCK = 128
CHUNK = 16
D_FF = 2816
ROPE_BASE = 10000.0
EPS = 1e-6
N_MOD = 9
NEG_BIG = -1e30
LB_FLOOR = 1e-30

kernel_name = 'hybrid_fourier_hgrn2_swa_diffusion_step'


def rmsnorm(x, w):
    xf = x.astype(jnp.float32)
    y = xf * lax.rsqrt(jnp.mean(xf * xf, axis=-1, keepdims=True) + EPS)
    return (y * w.astype(jnp.float32)).astype(x.dtype)


def modulate(x, g, shift, scale):
    return rmsnorm(x, g) * (1 + scale) + shift


def adaln(cond, w_ada, b_ada):
    m = jax.nn.silu(cond) @ w_ada + b_ada
    return m.reshape(cond.shape[0], 1, N_MOD, D_MODEL)


def swiglu(h, w_gu, w_down):
    g, u = jnp.split(h @ w_gu, 2, axis=-1)
    return (jax.nn.silu(g) * u) @ w_down


def split_in(z):
    idx = np.cumsum(SPLIT_SIZES)[:-1].tolist()
    return jnp.split(z, idx, axis=-1)


def fourier_mix(u):
    B, L, _ = u.shape
    ug = u.astype(jnp.float32).reshape(B, L, FOURIER_GROUPS, HEAD_DIM)
    f = jnp.fft.fft2(ug, axes=(1, 3), norm='ortho')
    return jnp.real(f).reshape(B, L, FOURIER_W).astype(u.dtype)


def gla_chunk_scan(q, k, v, logf, s0):
    B, L, H, DK = q.shape
    n = L // CHUNK
    rs = lambda t: t.reshape(B, n, CHUNK, H, t.shape[-1])
    qc, kc, vc, gc = rs(q), rs(k), rs(v), rs(logf)
    b = jnp.cumsum(gc, axis=2)
    bT = b[:, :, -1]
    causal = jnp.tril(jnp.ones((CHUNK, CHUNK), dtype=bool))[:, :, None, None]
    diff = b[:, :, :, None] - b[:, :, None, :]
    dec = jnp.where(causal, jnp.exp(jnp.where(causal, diff, 0.0)), 0.0)
    A = jnp.einsum('bnihk,bnijhk,bnjhk->bnhij', qc, dec, kc)
    o_intra = jnp.einsum('bnhij,bnjhv->bnihv', A, vc)
    q_in = qc * jnp.exp(b)
    k_out = kc * jnp.exp(bT[:, :, None] - b)

    def step(S, xs):
        qi, ki, vi, dT = xs
        o = jnp.einsum('bchk,bhkv->bchv', qi, S)
        S = S * jnp.exp(dT)[..., None] + jnp.einsum('bchk,bchv->bhkv', ki, vi)
        return S, o

    xs = (jnp.moveaxis(q_in, 1, 0), jnp.moveaxis(k_out, 1, 0),
          jnp.moveaxis(vc, 1, 0), jnp.moveaxis(bT, 1, 0))
    s_fin, o_inter = lax.scan(step, s0, xs)
    o = o_intra + jnp.moveaxis(o_inter, 0, 1)
    return o.reshape(B, L, H, v.shape[-1]), s_fin


def hgrn_mixer(hq, hi, hf_fwd, hf_bwd, hg, lb, norm_w, s0_fwd, s0_bwd):
    B, L, _ = hq.shape
    f32 = jnp.float32
    heads = lambda t: t.astype(f32).reshape(B, L, HGRN_HEADS, HEAD_DIM)
    q = heads(hq) * (HEAD_DIM ** -0.5)
    v = heads(hi)

    def gates(hf, lbd):
        z = hf.astype(f32)
        logf = jnp.logaddexp(jnp.log(jnp.maximum(lbd, LB_FLOOR)), jnp.log1p(-lbd) + jax.nn.log_sigmoid(z))
        kk = (1.0 - lbd) * jax.nn.sigmoid(-z)
        return heads(kk), heads(logf)

    k_f, g_f = gates(hf_fwd, lb[0])
    k_b, g_b = gates(hf_bwd, lb[1])
    o_f, s_f = gla_chunk_scan(q, k_f, v, g_f, s0_fwd.astype(f32))
    flip = lambda t: jnp.flip(t, axis=1)
    o_b, s_b = gla_chunk_scan(flip(q), flip(k_b), flip(v), flip(g_b), s0_bwd.astype(f32))
    o = o_f + flip(o_b)
    o = rmsnorm(o, norm_w.reshape(HGRN_HEADS, HEAD_DIM)) * jax.nn.silu(heads(hg))
    return o.reshape(B, L, HGRN_W).astype(hq.dtype), jnp.stack([s_f, s_b], axis=1)


def qkv_heads(aq, ak, av, q_norm, k_norm):
    B, L, _ = aq.shape
    q = rmsnorm(aq.reshape(B, L, ATTN_HEADS, HEAD_DIM), q_norm)
    q = q.reshape(B, L, ATTN_KV_HEADS, ATTN_GROUP, HEAD_DIM)
    k = rmsnorm(ak.reshape(B, L, ATTN_KV_HEADS, HEAD_DIM), k_norm)
    v = av.reshape(B, L, ATTN_KV_HEADS, HEAD_DIM)
    return q, k, v


def axial_rope(x):
    T = x.shape[1]
    rows = T // GRID_W
    row = jnp.repeat(jnp.arange(rows), GRID_W)
    col = jnp.tile(jnp.arange(GRID_W), rows)
    half = HEAD_DIM // 2
    inv = ROPE_BASE ** (-jnp.arange(0, half, 2, dtype=jnp.float32) / half)
    bshape = (T,) + (1,) * (x.ndim - 3) + (half // 2,)

    def rot(xa, pos):
        ang = pos.astype(jnp.float32)[:, None] * inv[None]
        cos = jnp.cos(ang).reshape(bshape)
        sin = jnp.sin(ang).reshape(bshape)
        x1, x2 = jnp.split(xa.astype(jnp.float32), 2, axis=-1)
        return jnp.concatenate([x1 * cos - x2 * sin, x2 * cos + x1 * sin], axis=-1)

    xr, xc = jnp.split(x, 2, axis=-1)
    return jnp.concatenate([rot(xr, row), rot(xc, col)], axis=-1).astype(x.dtype)


def context_attention(q, k, v, sink):
    scale = HEAD_DIM ** -0.5
    s = jnp.einsum('bqkgd,bskd->bkgqs', q, k).astype(jnp.float32) * scale
    sk = jnp.broadcast_to(sink.astype(jnp.float32).reshape(ATTN_KV_HEADS, ATTN_GROUP, 1, 1), s.shape[:-1] + (1,))
    p = jax.nn.softmax(jnp.concatenate([s, sk], axis=-1), axis=-1)[..., :-1]
    o = jnp.einsum('bkgqs,bskd->bqkgd', p.astype(v.dtype), v)
    B, L = q.shape[:2]
    return o.reshape(B, L, ATTN_W)


def latent_attention(q, k, v, kc, vc, sink):
    scale = HEAD_DIM ** -0.5
    B, T = q.shape[:2]
    nb = T // BLOCK
    qb = q.reshape(B, nb, BLOCK, ATTN_KV_HEADS, ATTN_GROUP, HEAD_DIM)
    pad = lambda t: jnp.pad(t, ((0, 0), (BLOCK, BLOCK), (0, 0), (0, 0))).reshape(B, nb + 2, BLOCK, ATTN_KV_HEADS, HEAD_DIM)
    win = lambda t: jnp.concatenate([t[:, :-2], t[:, 1:-1], t[:, 2:]], axis=2)
    kw, vw = win(pad(k)), win(pad(v))
    qpos = jnp.arange(nb)[:, None] * BLOCK + jnp.arange(BLOCK)[None]
    kpos = (jnp.arange(nb)[:, None] - 1) * BLOCK + jnp.arange(3 * BLOCK)[None]
    mask = (jnp.abs(qpos[:, :, None] - kpos[:, None, :]) <= WINDOW) & (kpos[:, None, :] >= 0) & (kpos[:, None, :] < T)
    s_loc = jnp.einsum('bnqkgd,bnskd->bnkgqs', qb, kw).astype(jnp.float32) * scale
    s_loc = jnp.where(mask[None, :, None, None], s_loc, NEG_BIG)
    s_ctx = jnp.einsum('bnqkgd,bskd->bnkgqs', qb, kc).astype(jnp.float32) * scale
    sk = jnp.broadcast_to(sink.astype(jnp.float32).reshape(ATTN_KV_HEADS, ATTN_GROUP, 1, 1), s_loc.shape[:-1] + (1,))
    p = jax.nn.softmax(jnp.concatenate([s_loc, s_ctx, sk], axis=-1), axis=-1)
    n_loc = 3 * BLOCK
    n_ctx = kc.shape[1]
    p_loc = p[..., :n_loc].astype(v.dtype)
    p_ctx = p[..., n_loc:n_loc + n_ctx].astype(v.dtype)
    o = jnp.einsum('bnkgqs,bnskd->bnqkgd', p_loc, vw) + jnp.einsum('bnkgqs,bskd->bnqkgd', p_ctx, vc)
    return o.reshape(B, T, ATTN_W)


def context_layer(x, mod, p):
    B = x.shape[0]
    x = x + 0.5 * mod[:, :, 2] * swiglu(modulate(x, p['norm_ffn1'], mod[:, :, 0], mod[:, :, 1]), p['ffn1_w_gate_up'], p['ffn1_w_down'])
    h = modulate(x, p['norm_mix'], mod[:, :, 3], mod[:, :, 4])
    u, hq, hi, hff, hfb, hg, aq, ak, av = split_in(h @ p['w_in'])
    fo = fourier_mix(u)
    zero = jnp.zeros((B, HGRN_HEADS, HEAD_DIM, HEAD_DIM), jnp.float32)
    ho, s_hgrn = hgrn_mixer(hq, hi, hff, hfb, hg, p['lb'], p['hgrn_norm'], zero, zero)
    q, k, v = qkv_heads(aq, ak, av, p['q_norm'], p['k_norm'])
    ao = context_attention(q, k, v, p['attn_sink'])
    x = x + mod[:, :, 5] * (jnp.concatenate([fo, ho, ao], axis=-1) @ p['w_out'])
    x = x + 0.5 * mod[:, :, 8] * swiglu(modulate(x, p['norm_ffn2'], mod[:, :, 6], mod[:, :, 7]), p['ffn2_w_gate_up'], p['ffn2_w_down'])
    return x, k, v, s_hgrn


def latent_layer(x, mod, kc, vc, s_ctx, p):
    x = x + 0.5 * mod[:, :, 2] * swiglu(modulate(x, p['norm_ffn1'], mod[:, :, 0], mod[:, :, 1]), p['ffn1_w_gate_up'], p['ffn1_w_down'])
    h = modulate(x, p['norm_mix'], mod[:, :, 3], mod[:, :, 4])
    u, hq, hi, hff, hfb, hg, aq, ak, av = split_in(h @ p['w_in'])
    fo = fourier_mix(u)
    ho, _ = hgrn_mixer(hq, hi, hff, hfb, hg, p['lb'], p['hgrn_norm'], s_ctx[:, 0], s_ctx[:, 1])
    q, k, v = qkv_heads(aq, ak, av, p['q_norm'], p['k_norm'])
    q, k = axial_rope(q), axial_rope(k)
    ao = latent_attention(q, k, v, kc, vc, p['attn_sink'])
    x = x + mod[:, :, 5] * (jnp.concatenate([fo, ho, ao], axis=-1) @ p['w_out'])
    x = x + 0.5 * mod[:, :, 8] * swiglu(modulate(x, p['norm_ffn2'], mod[:, :, 6], mod[:, :, 7]), p['ffn2_w_gate_up'], p['ffn2_w_down'])
    return x


def setup_inputs(seed: int = 0) -> dict:
    key = jax.random.key(seed)
    ks = jax.random.split(key, 23)
    nrm = lambda k, shape, s: jax.random.normal(k, shape, jnp.float32) * s
    gain = lambda k, shape: 1.0 + 0.05 * jax.random.normal(k, shape, jnp.float32)
    return {
        'x_prompt': nrm(ks[0], (BATCH, SEQ, D_MODEL), 1.0),
        'x_sample': nrm(ks[1], (DEC_BATCH, DEC_SEQ, D_MODEL), 1.0),
        'c': nrm(ks[2], (DEC_BATCH, D_MODEL), 1.0),
        'cache_attn_k': nrm(ks[3], (DEC_BATCH, DEPTH, PAST_LEN, ATTN_KV_HEADS, HEAD_DIM), 1.0),
        'cache_attn_v': nrm(ks[4], (DEC_BATCH, DEPTH, PAST_LEN, ATTN_KV_HEADS, HEAD_DIM), 1.0),
        'state_hgrn': nrm(ks[5], (DEC_BATCH, DEPTH, 2, HGRN_HEADS, HEAD_DIM, HEAD_DIM), 0.5),
        'c_ctx': nrm(ks[6], (D_MODEL,), 1.0),
        'w_ada': nrm(ks[7], (DEPTH, D_MODEL, N_MOD * D_MODEL), 0.5 * D_MODEL ** -0.5),
        'b_ada': nrm(ks[8], (DEPTH, N_MOD * D_MODEL), 0.01),
        'norm_ffn1': gain(ks[9], (DEPTH, D_MODEL)),
        'norm_mix': gain(ks[10], (DEPTH, D_MODEL)),
        'norm_ffn2': gain(ks[11], (DEPTH, D_MODEL)),
        'ffn1_w_gate_up': nrm(ks[12], (DEPTH, D_MODEL, 2 * D_FF), D_MODEL ** -0.5),
        'ffn1_w_down': nrm(ks[13], (DEPTH, D_FF, D_MODEL), D_FF ** -0.5),
        'ffn2_w_gate_up': nrm(ks[14], (DEPTH, D_MODEL, 2 * D_FF), D_MODEL ** -0.5),
        'ffn2_w_down': nrm(ks[15], (DEPTH, D_FF, D_MODEL), D_FF ** -0.5),
        'w_in': nrm(ks[16], (DEPTH, D_MODEL, IN_W), D_MODEL ** -0.5),
        'w_out': nrm(ks[17], (DEPTH, MIX_W, D_MODEL), MIX_W ** -0.5),
        'hgrn_lower_bounds': nrm(ks[18], (DEPTH, 2, HGRN_W), 1.0),
        'hgrn_norm': gain(ks[19], (DEPTH, HGRN_W)),
        'q_norm': gain(ks[20], (DEPTH, HEAD_DIM)),
        'k_norm': gain(ks[21], (DEPTH, HEAD_DIM)),
        'attn_sink': nrm(ks[22], (DEPTH, ATTN_HEADS), 0.5),
    }


def reference(x_prompt, x_sample, c, cache_attn_k, cache_attn_v, state_hgrn, c_ctx, w_ada, b_ada,
              norm_ffn1, norm_mix, norm_ffn2, ffn1_w_gate_up, ffn1_w_down, ffn2_w_gate_up, ffn2_w_down,
              w_in, w_out, hgrn_lower_bounds, hgrn_norm, q_norm, k_norm, attn_sink):
    lb_soft = jax.nn.softmax(hgrn_lower_bounds.astype(jnp.float32), axis=0)
    lower_bounds = jnp.cumsum(lb_soft, axis=0) - lb_soft[0]
    y_p = x_prompt
    y_s = x_sample
    k_list, v_list, s_list = [], [], []
    for l in range(DEPTH):
        p = {
            'norm_ffn1': norm_ffn1[l], 'norm_mix': norm_mix[l], 'norm_ffn2': norm_ffn2[l],
            'ffn1_w_gate_up': ffn1_w_gate_up[l], 'ffn1_w_down': ffn1_w_down[l],
            'ffn2_w_gate_up': ffn2_w_gate_up[l], 'ffn2_w_down': ffn2_w_down[l],
            'w_in': w_in[l], 'w_out': w_out[l], 'lb': lower_bounds[l], 'hgrn_norm': hgrn_norm[l],
            'q_norm': q_norm[l], 'k_norm': k_norm[l], 'attn_sink': attn_sink[l],
        }
        mod_ctx = adaln(c_ctx[None], w_ada[l], b_ada[l])
        mod_lat = adaln(c, w_ada[l], b_ada[l])
        y_p, k_l, v_l, s_l = context_layer(y_p, mod_ctx, p)
        y_s = latent_layer(y_s, mod_lat, cache_attn_k[:, l], cache_attn_v[:, l], state_hgrn[:, l], p)
        k_list.append(k_l)
        v_list.append(v_l)
        s_list.append(s_l)
    new_cache_attn_k = jnp.stack(k_list, axis=1)
    new_cache_attn_v = jnp.stack(v_list, axis=1)
    new_state_hgrn = jnp.stack(s_list, axis=1)
    return (y_p, y_s, new_cache_attn_k, new_cache_attn_v, new_state_hgrn)
```

```cpp
#include <hip/hip_runtime.h>
#include <cstdio>
#include <cstdint>
namespace pg8 {
#define PG8_LAS __attribute__((address_space(3)))
typedef unsigned short bf16_t;
typedef short bf16x8 __attribute__((ext_vector_type(8)));
typedef float f32x4 __attribute__((ext_vector_type(4)));
typedef unsigned u32x4 __attribute__((ext_vector_type(4)));
constexpr int BM = 256, BK = 64, HALF = 128, HTB = HALF * BK * 2  , STAGE_BYTES = 8 * HTB, NXCD = 8, WGM = 8;

__host__ __device__ __forceinline__ int lds_byte(int r, int c) { const int st = (r >> 4) * 2 + (c >> 5), rr = r & 15, cc = c & 31, ob = rr * 64 + cc * 2; return st * 1024 + (ob ^ (((ob >> 9) & 1) << 5)); }
__host__ __device__ __forceinline__ void stage_rc(int b, int& R, int& C) { const int st = b / 1024, sb = b % 1024, swz = sb ^ (((sb >> 9) & 1) << 5); R = (st >> 1) * 16 + swz / 64; C = (st & 1) * 32 + (swz % 64) / 2; }
__host__ __device__ __forceinline__ int perm32(int rho) { const int n = rho >> 4, i = rho & 15; return 8 * (i >> 2) + 4 * n + (i & 3); }

struct Unit { int pm, pn; };
struct Gemm { const bf16_t* A; const bf16_t* Bt; int M, N, K; };

struct StaticOrder {
    int nM, nN, nwg, G, c;
    __host__ __device__ void init(int M, int N, int G_, int c_) { nM = M / BM; nN = N / BM; nwg = nM * nN; G = G_; c = c_; }
    __host__ __device__ bool next(int i, Unit& u) const {
        const long L = (long)i * G + c; if (L >= nwg) return false;
        int wgid = (int)L; { const int q = nwg / NXCD, r = nwg % NXCD, xcd = wgid % NXCD, off = wgid / NXCD; wgid = (xcd < r ? xcd * (q + 1) : r * (q + 1) + (xcd - r) * q) + off; }
        const int nig = WGM * nN, gid = wgid / nig, fm = gid * WGM, gsz = (nM - fm) < WGM ? (nM - fm) : WGM;
        u.pm = fm + ((wgid % nig) % gsz); u.pn = (wgid % nig) / gsz; return true;
    }
    __device__ __forceinline__ void a_ready(const Unit&) const {}
    __device__ __forceinline__ void done(const Unit&) const {}
};

__device__ __forceinline__ unsigned cvt_pk_bf16(float lo, float hi) { unsigned r; asm volatile("v_cvt_pk_bf16_f32 %0, %1, %2" : "=v"(r) : "v"(lo), "v"(hi)); return r; }
typedef float f32x2 __attribute__((ext_vector_type(2)));
__device__ __forceinline__ f32x2 gelu_pk(f32x2 v) {
    const f32x2 av = __builtin_elementwise_abs(v), d = av * 0.2316418882f + 1.0f;
    f32x2 t; t.x = __builtin_amdgcn_rcpf(d.x); t.y = __builtin_amdgcn_rcpf(d.y);
    f32x2 q = t * 0.5307027145f + (-0.7265760135f); q = q * t + 0.7107068705f; q = q * t + (-0.142248368f); q = q * t + 0.127414796f; q = q * t;
    const f32x2 s = (v * v) * (-0.72134752044f);
    f32x2 e; e.x = __builtin_amdgcn_exp2f(s.x); e.y = __builtin_amdgcn_exp2f(s.y);
    const f32x2 m = v * (q * e), r = v - m;
    f32x2 o; o.x = v.x < 0.f ? m.x : r.x; o.y = v.y < 0.f ? m.y : r.y; return o;
}

template <int ACT  > struct EpiBf16 {
    static constexpr bool PERM = true, AFTER_DRAIN = false; static_assert(ACT == 0 || ACT == 1, "EpiBf16: ACT is 0 (none) or 1 (gelu_pk)");
    bf16_t* O; int ldc; const float* bias; int split_cols; size_t split_stride; float scale0;
    __device__ __forceinline__ void operator()(const f32x4 (&acc)[2][2][4][2], const Unit& u, int wr, int wc, int fr, int fq) const {
        const int row0 = u.pm * BM + wr * 64 + fr; int colt = u.pn * BM; bf16_t* base = O;
        float sc = 1.f; if (split_cols) { const int t = colt / split_cols; base += (size_t)t * split_stride; colt -= t * split_cols; if (t == 0) sc = scale0; }
        const int col0 = colt + wc * 32 + 8 * fq, bcol0 = u.pn * BM + wc * 32 + 8 * fq;
        f32x4 bv[2][2];
#pragma unroll
        for (int bj = 0; bj < 2; ++bj)
#pragma unroll
            for (int n = 0; n < 2; ++n) bv[bj][n] = bias ? *(const f32x4*)(bias + bcol0 + bj * HALF + 4 * n) : (f32x4){0.f, 0.f, 0.f, 0.f};
#pragma unroll
        for (int ai = 0; ai < 2; ++ai)
#pragma unroll
            for (int m = 0; m < 4; ++m) { bf16_t* rowp = base + (size_t)(row0 + ai * HALF + m * 16) * ldc + col0;
#pragma unroll
                for (int bj = 0; bj < 2; ++bj) { f32x4 v0 = acc[ai][bj][m][0] + bv[bj][0], v1 = acc[ai][bj][m][1] + bv[bj][1];
                    if (ACT == 1) { f32x2 a = gelu_pk((f32x2){v0[0], v0[1]}), b = gelu_pk((f32x2){v0[2], v0[3]}), c = gelu_pk((f32x2){v1[0], v1[1]}), d = gelu_pk((f32x2){v1[2], v1[3]});
                        v0 = (f32x4){a.x, a.y, b.x, b.y}; v1 = (f32x4){c.x, c.y, d.x, d.y}; }
                    v0 = v0 * sc; v1 = v1 * sc; u32x4 w; w.x = cvt_pk_bf16(v0[0], v0[1]); w.y = cvt_pk_bf16(v0[2], v0[3]); w.z = cvt_pk_bf16(v1[0], v1[1]); w.w = cvt_pk_bf16(v1[2], v1[3]);
                    *(u32x4*)(rowp + bj * HALF) = w; } }
    }
};
struct EpiSwiglu {
    static constexpr bool PERM = true, AFTER_DRAIN = false;
    bf16_t* O; int ldc;
    __device__ __forceinline__ void operator()(const f32x4 (&acc)[2][2][4][2], const Unit& u, int wr, int wc, int fr, int fq) const {
        const int row0 = u.pm * BM + wr * 64 + fr; const int col0 = u.pn * HALF + wc * 32 + 8 * fq;
#pragma unroll
        for (int ai = 0; ai < 2; ++ai)
#pragma unroll
            for (int m = 0; m < 4; ++m) { bf16_t* rowp = O + (size_t)(row0 + ai * HALF + m * 16) * ldc + col0;
                float a[8];
#pragma unroll
                for (int n = 0; n < 2; ++n)
#pragma unroll
                    for (int i = 0; i < 4; ++i) { const float g = acc[ai][0][m][n][i], uu = acc[ai][1][m][n][i];
                        const float sg = g * __builtin_amdgcn_rcpf(1.0f + __builtin_amdgcn_exp2f(-1.4426950408889634f * g)); a[n * 4 + i] = sg * uu; }
                u32x4 w; w.x = cvt_pk_bf16(a[0], a[1]); w.y = cvt_pk_bf16(a[2], a[3]); w.z = cvt_pk_bf16(a[4], a[5]); w.w = cvt_pk_bf16(a[6], a[7]);
                *(u32x4*)rowp = w; }
    }
};
struct EpiRes {
    static constexpr bool PERM = false, AFTER_DRAIN = false;
    const float* base0; const float* base1; float* out; const float* gate;
    __device__ __forceinline__ void operator()(const f32x4 (&acc)[2][2][4][2], const Unit& u, int wr, int wc, int fr, int fq) const {
        const int col0 = u.pn * BM + wc * 32 + 4 * fq; const int cond = u.pm < 32 ? 0 : 1 + ((u.pm - 32) >> 2);
        const float* base = u.pm < 32 ? base0 : base1;
        f32x4 gv[2][2];
#pragma unroll
        for (int bj = 0; bj < 2; ++bj)
#pragma unroll
            for (int n = 0; n < 2; ++n) gv[bj][n] = *(const f32x4*)(gate + cond * 1024 + col0 + bj * HALF + n * 16);
#pragma unroll
        for (int ai = 0; ai < 2; ++ai)
#pragma unroll
            for (int m = 0; m < 4; ++m) { const size_t off = (size_t)(u.pm * BM + ai * HALF + wr * 64 + m * 16 + fr) * 1024 + col0;
#pragma unroll
                for (int bj = 0; bj < 2; ++bj)
#pragma unroll
                    for (int n = 0; n < 2; ++n) { const f32x4 bs = *(const f32x4*)(base + off + bj * HALF + n * 16);
                        *(f32x4*)(out + off + bj * HALF + n * 16) = bs + gv[bj][n] * acc[ai][bj][m][n]; } }
    }
};
template <class Epi, class Sched, bool ALIGN_EPI = false, bool SP2 = false>
__device__ __forceinline__ void gemm_phase(PG8_LAS unsigned char* lds, const Gemm g, const Sched& S, const Epi& E, int tid_in) {
    const int tid = tid_in, wid = __builtin_amdgcn_readfirstlane(tid >> 6), lane = tid & 63, wr = wid >> 2, wc = wid & 3, fr = lane & 15, fq = lane >> 4;
    const int K = g.K, nt = K / BK;
    unsigned voffA[2], voffB[2];
#pragma unroll
    for (int i = 0; i < 2; ++i) { int R, C; stage_rc(tid * 16 + i * 8192, R, C); const int Rb = Epi::PERM ? ((R & ~31) + perm32(R & 31)) : R;
        voffA[i] = (unsigned)(R * K + C) * 2u; voffB[i] = (unsigned)(Rb * K + C) * 2u; }
    const size_t kstep = (size_t)(BK * 2);
    const size_t hstep = (size_t)HALF * K * 2;
    const size_t tstep = 2 * hstep;
    const unsigned ldsw = (unsigned)wid * 1024u;
    const int aoff = lds_byte(wr * 64 + fr, fq * 8), boff = lds_byte(wc * 32 + fr, fq * 8);
#define PG8_SA(b, h) (((b) * 2 + (h)) * HTB)
#define PG8_SB(b, h) ((4 + (b) * 2 + (h)) * HTB)
#define PG8_STAGE(bufoff, gbase, voff) do { _Pragma("unroll") for (int _i = 0; _i < 2; ++_i) \
        __builtin_amdgcn_global_load_lds((const unsigned*)((const char*)(gbase) + (voff)[_i]), (PG8_LAS unsigned*)(lds + (bufoff) + ldsw + _i * 8192), 16, 0, 0); } while (0)
#define PG8_LDA(dst, b, h) do { _Pragma("unroll") for (int m = 0; m < 4; ++m) _Pragma("unroll") for (int k = 0; k < 2; ++k) dst[m][k] = *(const PG8_LAS bf16x8*)(lds + PG8_SA(b, h) + aoff + m * 2048 + k * 1024); } while (0)
#define PG8_LDB(dst, b, h) do { _Pragma("unroll") for (int n = 0; n < 2; ++n) _Pragma("unroll") for (int k = 0; k < 2; ++k) dst[n][k] = *(const PG8_LAS bf16x8*)(lds + PG8_SB(b, h) + boff + n * 2048 + k * 1024); } while (0)
#define PG8_MMA(ai, bj, At, Bt) do { __builtin_amdgcn_s_setprio(1); _Pragma("unroll") for (int m = 0; m < 4; ++m) _Pragma("unroll") for (int n = 0; n < 2; ++n) _Pragma("unroll") for (int k = 0; k < 2; ++k) \
        acc[ai][bj][m][n] = __builtin_amdgcn_mfma_f32_16x16x32_bf16(Bt[n][k], At[m][k], acc[ai][bj][m][n], 0, 0, 0); __builtin_amdgcn_s_setprio(0); } while (0)
#define PG8_WAIT_V(n) asm volatile("s_waitcnt vmcnt(" #n ")" ::: "memory")
#define PG8_WAIT_L(n) asm volatile("s_waitcnt lgkmcnt(" #n ")" ::: "memory")
#define PG8_BAR __builtin_amdgcn_s_barrier()
#define PG8_SCHED __builtin_amdgcn_sched_barrier(0)
    Unit cur, nxt; int ui = 0;
    if (!S.next(0, cur)) return;
    f32x4 acc[2][2][4][2];
#pragma unroll
    for (int a = 0; a < 2; ++a)
#pragma unroll
        for (int b = 0; b < 2; ++b)
#pragma unroll
            for (int m = 0; m < 4; ++m)
#pragma unroll
                for (int n = 0; n < 2; ++n) acc[a][b][m][n] = (f32x4){0.f, 0.f, 0.f, 0.f};
    bf16x8 At[4][2], B0[2][2], B1[2][2];
    const char* cA = (const char*)g.A + (size_t)cur.pm * tstep; const char* cB = (const char*)g.Bt + (size_t)cur.pn * tstep;
    S.a_ready(cur);
    if constexpr (SP2) {
        PG8_STAGE(PG8_SB(0, 0), cB, voffB); PG8_STAGE(PG8_SB(0, 1), cB + hstep, voffB); PG8_STAGE(PG8_SA(0, 0), cA, voffA); PG8_STAGE(PG8_SA(0, 1), cA + hstep, voffA);
        if (wr == 1) PG8_BAR;
        PG8_WAIT_V(2); PG8_BAR;
        PG8_STAGE(PG8_SB(1, 0), cB + kstep, voffB); PG8_STAGE(PG8_SA(1, 0), cA + kstep, voffA); PG8_STAGE(PG8_SB(1, 1), cB + hstep + kstep, voffB);
        PG8_WAIT_V(6); PG8_BAR;
    } else {
        PG8_STAGE(PG8_SB(0, 0), cB, voffB); PG8_STAGE(PG8_SA(0, 0), cA, voffA); PG8_STAGE(PG8_SB(0, 1), cB + hstep, voffB); PG8_STAGE(PG8_SA(0, 1), cA + hstep, voffA);
        if (wr == 1) PG8_BAR;
        PG8_WAIT_V(4); PG8_BAR;
        PG8_STAGE(PG8_SB(1, 0), cB + kstep, voffB); PG8_STAGE(PG8_SA(1, 0), cA + kstep, voffA); PG8_STAGE(PG8_SB(1, 1), cB + hstep + kstep, voffB);
        PG8_WAIT_V(6); PG8_BAR;
    }
    for (;;) {
        const bool has_next = S.next(ui + 1, nxt);
        const char* nA = has_next ? (const char*)g.A + (size_t)nxt.pm * tstep : cA; const char* nB = has_next ? (const char*)g.Bt + (size_t)nxt.pn * tstep : cB;
        for (int t = 0; t < nt; t += 2) {
            const bool last = (t == nt - 2);
            const char* a1 = cA + (size_t)(t + 1) * kstep;
            const char* a2 = last ? nA : cA + (size_t)(t + 2) * kstep; const char* b2 = last ? nB : cB + (size_t)(t + 2) * kstep;
            const char* a3 = a2 + kstep; const char* b3 = b2 + kstep;
            if (last && has_next) S.a_ready(nxt);
            if constexpr (SP2) {
            PG8_LDB(B0, 0, 0); PG8_LDB(B1, 0, 1); PG8_SCHED; PG8_LDA(At, 0, 0); PG8_STAGE(PG8_SA(1, 1), a1 + hstep, voffA);
            PG8_WAIT_V(8); PG8_WAIT_L(0); PG8_BAR; PG8_MMA(0, 0, At, B0); PG8_MMA(0, 1, At, B1); PG8_BAR; PG8_SCHED;
            PG8_LDA(At, 0, 1); PG8_STAGE(PG8_SB(0, 0), b2, voffB); PG8_STAGE(PG8_SB(0, 1), b2 + hstep, voffB); PG8_STAGE(PG8_SA(0, 0), a2, voffA);
            PG8_WAIT_V(8); PG8_WAIT_L(0); PG8_BAR; PG8_MMA(1, 0, At, B0); PG8_MMA(1, 1, At, B1); PG8_BAR; PG8_SCHED;
            PG8_LDB(B0, 1, 0); PG8_LDB(B1, 1, 1); PG8_SCHED; PG8_LDA(At, 1, 0); PG8_STAGE(PG8_SA(0, 1), a2 + hstep, voffA);
            PG8_WAIT_V(8); PG8_WAIT_L(0); PG8_BAR; PG8_MMA(0, 0, At, B0); PG8_MMA(0, 1, At, B1); PG8_BAR; PG8_SCHED;
            PG8_LDA(At, 1, 1); PG8_STAGE(PG8_SB(1, 0), b3, voffB); PG8_STAGE(PG8_SB(1, 1), b3 + hstep, voffB); PG8_STAGE(PG8_SA(1, 0), a3, voffA);
            PG8_WAIT_V(8); PG8_WAIT_L(0); PG8_BAR; PG8_MMA(1, 0, At, B0); PG8_MMA(1, 1, At, B1); PG8_BAR; PG8_SCHED;
            } else {
            PG8_LDB(B0, 0, 0); PG8_SCHED; PG8_LDA(At, 0, 0); PG8_STAGE(PG8_SA(1, 1), a1 + hstep, voffA);
            PG8_WAIT_L(8); PG8_BAR; PG8_WAIT_L(0); PG8_MMA(0, 0, At, B0); PG8_BAR; PG8_SCHED;
            PG8_LDB(B1, 0, 1); PG8_STAGE(PG8_SB(0, 0), b2, voffB);
            PG8_BAR; PG8_WAIT_L(0); PG8_MMA(0, 1, At, B1); PG8_BAR;
            PG8_LDA(At, 0, 1); PG8_STAGE(PG8_SA(0, 0), a2, voffA);
            PG8_BAR; PG8_WAIT_L(0); PG8_MMA(1, 0, At, B0); PG8_BAR; PG8_SCHED;
            PG8_STAGE(PG8_SB(0, 1), b2 + hstep, voffB);
            PG8_WAIT_V(6); PG8_BAR; PG8_MMA(1, 1, At, B1); PG8_BAR;
            PG8_LDB(B0, 1, 0); PG8_SCHED; PG8_LDA(At, 1, 0); PG8_STAGE(PG8_SA(0, 1), a2 + hstep, voffA);
            PG8_WAIT_L(8); PG8_BAR; PG8_WAIT_L(0); PG8_MMA(0, 0, At, B0); PG8_BAR; PG8_SCHED;
            PG8_LDB(B1, 1, 1); PG8_STAGE(PG8_SB(1, 0), b3, voffB);
            PG8_BAR; PG8_WAIT_L(0); PG8_MMA(0, 1, At, B1); PG8_BAR;
            PG8_LDA(At, 1, 1); PG8_STAGE(PG8_SA(1, 0), a3, voffA);
            PG8_BAR; PG8_WAIT_L(0); PG8_MMA(1, 0, At, B0); PG8_BAR; PG8_SCHED;
            PG8_STAGE(PG8_SB(1, 1), b3 + hstep, voffB);
            PG8_WAIT_V(6); PG8_BAR; PG8_MMA(1, 1, At, B1); PG8_BAR;
            }
        }
        if constexpr (ALIGN_EPI) { if (wr == 0) PG8_BAR; }
        if constexpr (!Epi::AFTER_DRAIN) { E(acc, cur, wr, wc, fr, fq); S.done(cur); }
        if (!has_next) break;
#pragma unroll
        for (int a = 0; a < 2; ++a)
#pragma unroll
            for (int b = 0; b < 2; ++b)
#pragma unroll
                for (int m = 0; m < 4; ++m)
#pragma unroll
                    for (int n = 0; n < 2; ++n) acc[a][b][m][n] = (f32x4){0.f, 0.f, 0.f, 0.f};
        cur = nxt; cA = nA; cB = nB; ++ui;
        if constexpr (ALIGN_EPI) { if (wr == 1) PG8_BAR; }
    }
    PG8_WAIT_V(0);
    if constexpr (!ALIGN_EPI) { if (wr == 0) PG8_BAR; }
    PG8_BAR;
    if constexpr (Epi::AFTER_DRAIN) { E.fused(acc, cur, wr, wc, fr, fq, lds, wid, lane); S.done(cur); }
#undef PG8_SA
#undef PG8_SB
#undef PG8_STAGE
#undef PG8_LDA
#undef PG8_LDB
#undef PG8_MMA
#undef PG8_WAIT_V
#undef PG8_WAIT_L
#undef PG8_BAR
#undef PG8_SCHED
}
}
#define GAS __attribute__((address_space(1)))
#define LAS __attribute__((address_space(3)))
typedef unsigned short bf16;
typedef unsigned v4u __attribute__((ext_vector_type(4)));
typedef float f32x4 __attribute__((ext_vector_type(4)));
typedef short bf16x8 __attribute__((ext_vector_type(8)));
typedef GAS unsigned gu32;
typedef GAS unsigned long long gu64;
#define RLX_AGENT __ATOMIC_RELAXED, __HIP_MEMORY_SCOPE_AGENT
#define LDS_WAIT() asm volatile("s_waitcnt lgkmcnt(0)" ::: "memory")
#define VM_WAIT() asm volatile("s_waitcnt vmcnt(0)" ::: "memory")
__device__ __forceinline__ unsigned long long rt() { return __builtin_amdgcn_s_memrealtime(); }
__device__ __forceinline__ unsigned f2bf(float f) { unsigned u = __builtin_bit_cast(unsigned, f); return (u + 0x7fffu + ((u >> 16) & 1u)) >> 16; }
__device__ __forceinline__ unsigned pk2(float lo, float hi) { return f2bf(lo) | (f2bf(hi) << 16); }

#define XB_TMO      128
#define XB_XCNT(j)  (256  + 64 * (j))
#define XB_XSUB(j)  (1280 + 64 * (j))
#define XB_XGEN(j)  (2304 + 64 * (j))
#define XB_TOP      3328
#define XB_TOPGEN   3392
#define XCD_BAR_WORDS 3456
#define XB_SPIN_CAP (1u << 18)

__device__ __forceinline__ unsigned xb_ld(unsigned* p)              { return __hip_atomic_load(p, __ATOMIC_RELAXED, __HIP_MEMORY_SCOPE_AGENT); }
__device__ __forceinline__ unsigned xb_add(unsigned* p, unsigned v) { return __hip_atomic_fetch_add(p, v, __ATOMIC_RELAXED, __HIP_MEMORY_SCOPE_AGENT); }
__device__ __forceinline__ unsigned xb_xcc_id() { return (unsigned)__builtin_amdgcn_s_getreg((3 << 11) | 20) & 0xFu; }
#define XB_SPIN(cond, bar) do { unsigned _sp = 0; while (cond) { __builtin_amdgcn_s_sleep(1); \
    if ((++_sp & 255u) == 0u) { if (xb_ld(&(bar)[XB_TMO])) break; if (_sp > XB_SPIN_CAP) { atomicAdd(&(bar)[XB_TMO], 1u); break; } } } } while (0)

struct XcdBarrier {
    unsigned* bar; unsigned x;
    volatile LAS unsigned* st;
};

__device__ __forceinline__ XcdBarrier xcd_barrier_post(unsigned* bar, volatile LAS unsigned* st) {
    XcdBarrier b; b.bar = bar; b.x = xb_xcc_id(); b.st = st;
    if (threadIdx.x == 0) (void)xb_add(&bar[XB_XCNT(b.x)], 1u);
    return b;
}
__device__ __forceinline__ void xcd_barrier_complete(unsigned* bar, unsigned x, unsigned& nloc, unsigned& nx) {
    const unsigned G = gridDim.x * gridDim.y * gridDim.z;
    unsigned sum, cnt, mine, sp = 0u;
    for (;;) {
        sum = 0u; cnt = 0u; mine = 0u;
#pragma unroll
        for (unsigned j = 0; j < 16; ++j) { const unsigned c = xb_ld(&bar[XB_XCNT(j)]); sum += c; cnt += (c > 0u) ? 1u : 0u; mine = (j == x) ? c : mine; }
        if (sum == G) break;
        __builtin_amdgcn_s_sleep(1);
        if ((++sp & 255u) == 0u) { if (xb_ld(&bar[XB_TMO])) break; if (sp > XB_SPIN_CAP) { atomicAdd(&bar[XB_TMO], 1u); break; } }
    }
    nloc = mine > 0u ? mine : 1u; nx = cnt > 0u ? cnt : 1u;
}

__device__ __forceinline__ void xcd_barrier(const XcdBarrier& b) {
    asm volatile("s_waitcnt vmcnt(0)" ::: "memory");
    __syncthreads();
    if (threadIdx.x == 0) {
        unsigned* bar = b.bar;
        __builtin_amdgcn_s_waitcnt(0);
        unsigned nloc = b.st[0], nx = b.st[1];
        if (nloc == 0u) { xcd_barrier_complete(bar, b.x, nloc, nx); b.st[0] = nloc; b.st[1] = nx; }
        const unsigned old = xb_add(&bar[XB_XSUB(b.x)], 1u);
        const unsigned gen = old / nloc;
        if (old + 1u == (gen + 1u) * nloc) {
            __builtin_amdgcn_fence(__ATOMIC_RELEASE, "agent");
            asm volatile("s_waitcnt vmcnt(0)" ::: "memory");
            const unsigned og = xb_add(&bar[XB_TOP], 1u);
            const unsigned tg = og / nx;
            if (og + 1u == (tg + 1u) * nx) xb_add(&bar[XB_TOPGEN], 1u);
            else XB_SPIN(xb_ld(&bar[XB_TOPGEN]) == tg, bar);
            __builtin_amdgcn_fence(__ATOMIC_ACQUIRE, "agent");
            xb_add(&bar[XB_XGEN(b.x)], 1u);
            asm volatile("s_waitcnt vmcnt(0)" ::: "memory");
        } else {
            XB_SPIN(xb_ld(&bar[XB_XGEN(b.x)]) == gen, bar);
            __builtin_amdgcn_fence(__ATOMIC_ACQUIRE, "agent");
            asm volatile("s_waitcnt vmcnt(0)" ::: "memory");
        }
    }
    __syncthreads();
}

constexpr int NWAVES = 8;
constexpr int D = 1024, M = 12288, MC = 8192, FF = 2816, NGU = 5632, ZW = 2560;
constexpr int ZC_Y = 0, ZC_HQ = 512, ZC_HI = 768, ZC_HFF = 1024, ZC_HFB = 1280, ZC_HG = 1536, ZC_AQ = 1792, ZC_AK = 2304, ZC_AV = 2432;
constexpr int NCHUNK = M / 32;
constexpr float QSCALE = 0.125f * 1.4426950408889634f;
constexpr float LOG2E = 1.4426950408889634f;
constexpr size_t MiB = 1u << 20;
constexpr size_t WS_CTL = 0, CTL_ZERO_BYTES = 1 * MiB;
constexpr size_t WS_MODP = 1 * MiB;
constexpr size_t WS_MODT = 7 * MiB;
constexpr size_t WS_T1024 = 8 * MiB, WS_T256 = 12 * MiB;
constexpr size_t WS_KC = 13 * MiB, WS_VCT = 14 * MiB;
constexpr size_t WS_WGU = 16 * MiB, WGU_SZ = 11 * MiB;
constexpr size_t WS_WDN = 60 * MiB, WDN_SZ = 11 * MiB / 2;
constexpr size_t WS_WIN = 82 * MiB, WIN_SZ = 5 * MiB;
constexpr size_t WS_WOUT = 92 * MiB, WOUT_SZ = 2 * MiB;
constexpr size_t WS_H = 96 * MiB;
constexpr size_t WS_QR = 96 * MiB, WS_KR = 108 * MiB;
constexpr size_t WS_ACT = 120 * MiB;
constexpr size_t WS_Z = 120 * MiB, WS_EB = 180 * MiB, WS_VTP = 181 * MiB;
constexpr size_t WS_MIX = 186 * MiB;
constexpr size_t WS_QINP = 210 * MiB, WS_KOUTT = 222 * MiB, WS_VT = 234 * MiB, WS_YT = 246 * MiB, WS_OSC = 258 * MiB, WS_END = 270 * MiB;
constexpr int CW_BAR = 4096;
constexpr int CW_Q = 16384;
constexpr int RING_BYTES = 131072, LDSCTL_OFF = RING_BYTES, MISC_OFF = LDSCTL_OFF + 320, LDS_BYTES = 147456;
constexpr int OUT_YP = 0, OUT_YS = 8388608, OUT_CK = 12582912, OUT_CV = 14680064, OUT_ST = 16777216, OUT_TOTAL = 18874368;

typedef float f32x16 __attribute__((ext_vector_type(16)));
typedef unsigned u32x2 __attribute__((ext_vector_type(2)));
__device__ __forceinline__ float bf2f(unsigned b) { return __uint_as_float(b << 16); }
__device__ __forceinline__ float ex2(float x) { return __builtin_amdgcn_exp2f(x); }
__device__ __forceinline__ float expf_fast(float x) { return __builtin_amdgcn_exp2f(x * LOG2E); }
__device__ __forceinline__ int swap23(int s) { return (s & ~12) | ((s & 4) << 1) | ((s & 8) >> 1); }
__device__ __forceinline__ bf16x8 pack8(const float* a) { v4u w; w.x = pk2(a[0], a[1]); w.y = pk2(a[2], a[3]); w.z = pk2(a[4], a[5]); w.w = pk2(a[6], a[7]); return __builtin_bit_cast(bf16x8, w); }
__device__ __forceinline__ int krow(int reg, int h) { return (reg & 3) + 8 * (reg >> 2) + 4 * h; }

typedef const float* fptr_t;
#define KIN(i) (((const fptr_t __attribute__((address_space(4)))*)__builtin_amdgcn_kernarg_segment_ptr())[i])
struct Frame {
    LAS unsigned char* lds; volatile LAS unsigned* MISC; gu32* ctl;
    int tid, lane, wave, G;
    float* out; unsigned char* ws;
};

__device__ __forceinline__ void p0_transpose_item(const float* W, int ldw, bf16* WT, int K, int dst_row0, int src_col0, int k0, LAS float* scr, int lane) {
    float v[32];
#pragma unroll
    for (int i = 0; i < 32; ++i) { const int kk = 2 * i + (lane >> 5); v[i] = W[(size_t)(k0 + kk) * ldw + src_col0 + (lane & 31)]; }
#pragma unroll
    for (int i = 0; i < 32; ++i) { const int kk = 2 * i + (lane >> 5); scr[kk * 33 + (lane & 31)] = v[i]; }
    LDS_WAIT(); asm volatile("" ::: "memory");
    const int c = lane & 7;
#pragma unroll
    for (int j = 0; j < 4; ++j) { const int n = (lane >> 3) + 8 * j; const LAS float* s = scr + (8 * c) * 33 + n;
        v4u o; o.x = pk2(s[0 * 33], s[1 * 33]); o.y = pk2(s[2 * 33], s[3 * 33]); o.z = pk2(s[4 * 33], s[5 * 33]); o.w = pk2(s[6 * 33], s[7 * 33]);
        *(GAS v4u*)(WT + (size_t)(dst_row0 + n) * K + k0 + 8 * c) = o; }
    LDS_WAIT(); asm volatile("" ::: "memory");
}
__device__ __forceinline__ void p0_fold_item(const float* Win, bf16* WT, int n0, int k0, LAS float* scr, int lane) {
    const int comp = n0 >> 8, g = (n0 & 255) >> 6, c0 = n0 & 63;
    LAS float* tw = scr + 32 * 65; LAS float* scr2 = tw + 64;
    tw[lane] = __builtin_amdgcn_cosf((float)lane * (1.0f / 64.0f)) * 0.125f;
#pragma unroll 8
    for (int i = 0; i < 32; ++i) scr[i * 65 + lane] = Win[(size_t)(k0 + i) * 2304 + g * 64 + lane];
    LDS_WAIT(); asm volatile("" ::: "memory");
    const int kk = lane & 31, ch = lane >> 5;
    for (int ci = 0; ci < 16; ++ci) { const int cl = ch * 16 + ci, c = c0 + cl; float a = 0.f;
#pragma unroll 8
        for (int d = 0; d < 64; ++d) { const int idx = (c * d) & 63; const float t = comp ? -tw[(idx - 16) & 63] : tw[idx]; a += scr[kk * 65 + d] * t; }
        scr2[cl * 33 + kk] = a; }
    LDS_WAIT(); asm volatile("" ::: "memory");
#pragma unroll
    for (int j = 0; j < 2; ++j) { const int q = lane + 64 * j, c = q >> 2, kc = q & 3; const LAS float* s = scr2 + c * 33 + 8 * kc;
        v4u o; o.x = pk2(s[0], s[1]); o.y = pk2(s[2], s[3]); o.z = pk2(s[4], s[5]); o.w = pk2(s[6], s[7]);
        *(GAS v4u*)(WT + (size_t)(n0 + c) * 1024 + k0 + 8 * kc) = o; }
    LDS_WAIT(); asm volatile("" ::: "memory");
}
__device__ __forceinline__ void p0_mod_item(Frame& F, int it, int lane) {
    const int l = it / 576, rem = it % 576, cb = rem >> 4, ks = rem & 15;
    const int k = ks * 64 + lane;
    float sv[5];
    { const float x = KIN(6)[k]; sv[0] = x * __builtin_amdgcn_rcpf(1.0f + expf_fast(-x)); }
#pragma unroll
    for (int c = 1; c < 5; ++c) { const float x = KIN(2)[(c - 1) * 1024 + k]; sv[c] = x * __builtin_amdgcn_rcpf(1.0f + expf_fast(-x)); }
    f32x4 acc[5];
#pragma unroll
    for (int c = 0; c < 5; ++c) acc[c] = (f32x4){0.f, 0.f, 0.f, 0.f};
    const float* wp = KIN(7) + ((size_t)l * 1024 + ks * 64) * 9216 + cb * 256 + lane * 4;
#pragma unroll 8
    for (int kk = 0; kk < 64; ++kk) { const f32x4 w = *(const f32x4*)(wp + (size_t)kk * 9216);
#pragma unroll
        for (int c = 0; c < 5; ++c) { const float s = __shfl(sv[c], kk); acc[c] += w * s; } }
    float* mp = (float*)(F.ws + WS_MODP);
#pragma unroll
    for (int c = 0; c < 5; ++c) *(f32x4*)(mp + ((size_t)((ks * 2 + l) * 5 + c)) * 9216 + cb * 256 + lane * 4) = acc[c];
}
__device__ __forceinline__ void p0_twiddle_row(bf16* T, int L, int p, int lane) {
    const float sc = L == 1024 ? 0.03125f : 0.0625f, invL = 1.0f / (float)L;
    for (int j = 0; j < (2 * L) / 512; ++j) { const int col0 = (j * 64 + lane) * 8; float a[8];
#pragma unroll
        for (int i = 0; i < 8; ++i) { const int col = col0 + i, comp = col >= L, t = col - comp * L; const float x = (float)((p * t) & (L - 1)) * invL;
            a[i] = (comp ? __builtin_amdgcn_sinf(x) : __builtin_amdgcn_cosf(x)) * sc; }
        *(GAS bf16x8*)(T + (size_t)p * 2 * L + col0) = pack8(a); }
}
__device__ __forceinline__ void p0_cache_item(Frame& F, int it, int lane) {
    const int blk = it & 15, kvh = (it >> 4) & 1, bl = it >> 5;
    bf16* KC = (bf16*)(F.ws + WS_KC); bf16* VCT = (bf16*)(F.ws + WS_VCT);
    float vv[32];
#pragma unroll
    for (int i = 0; i < 32; ++i) { const size_t src = (((size_t)bl * 512 + blk * 32 + i) * 2 + kvh) * 64 + lane;
        KC[(((size_t)bl * 2 + kvh) * 512 + blk * 32 + i) * 64 + lane] = (bf16)f2bf(KIN(3)[src]); vv[i] = KIN(4)[src]; }
    float a[32];
#pragma unroll
    for (int s = 0; s < 32; ++s) a[s] = vv[swap23(s)];
    bf16* dst = VCT + (((size_t)bl * 2 + kvh) * 64 + lane) * 512 + blk * 32;
#pragma unroll
    for (int j = 0; j < 4; ++j) *(GAS bf16x8*)(dst + 8 * j) = pack8(a + 8 * j);
}
__device__ __forceinline__ void p0_prologue(Frame& F) {
    LAS float* scr = (LAS float*)(F.lds + F.wave * 16384);
    const int gw = blockIdx.x * NWAVES + F.wave, NGW = F.G * NWAVES;
    constexpr int I_GU = 16 * 176, I_DN = 44 * 32, I_WIN = 16 * 64, I_FOLD = 32 * 16, I_WOUT = 16 * 32, I_LAYER = 2 * I_GU + 2 * I_DN + I_WIN + I_FOLD + I_WOUT;
    constexpr int I_W = 2 * I_LAYER, I_MOD = 2 * 576, I_TW = 1024 + 256, I_CACHE = 256, NITEMS = I_MOD + I_W + I_TW + I_CACHE;
    for (int it = gw; it < NITEMS; it += NGW) {
        int r = it;
        if (r < I_MOD) { p0_mod_item(F, r, F.lane); continue; } r -= I_MOD;
        if (r < I_W) { const int l = r / I_LAYER; r -= l * I_LAYER;
            if (r < 2 * I_GU) { const int f = r / I_GU; r -= f * I_GU; const int kb = r / 176, nb = r % 176, n0 = 32 * nb;
                const int src = ((n0 >> 7) & 1) * FF + 128 * (n0 >> 8) + (n0 & 127);
                p0_transpose_item(KIN(f ? 14 : 12) + (size_t)l * D * NGU, NGU, (bf16*)(F.ws + WS_WGU + (size_t)(l * 2 + f) * WGU_SZ), D, n0, src, 64 * kb, scr, F.lane); continue; }
            r -= 2 * I_GU;
            if (r < 2 * I_DN) { const int f = r / I_DN; r -= f * I_DN; const int kb = r / 32, nb = r % 32;
                p0_transpose_item(KIN(f ? 15 : 13) + (size_t)l * FF * D, D, (bf16*)(F.ws + WS_WDN + (size_t)(l * 2 + f) * WDN_SZ), FF, 32 * nb, 32 * nb, 64 * kb, scr, F.lane); continue; }
            r -= 2 * I_DN;
            if (r < I_WIN) { const int kb = r / 64, nb = r % 64;
                p0_transpose_item(KIN(16) + (size_t)l * D * 2304, 2304, (bf16*)(F.ws + WS_WIN + (size_t)l * WIN_SZ), D, 512 + 32 * nb, 256 + 32 * nb, 64 * kb, scr, F.lane); continue; }
            r -= I_WIN;
            if (r < I_FOLD) { const int kb = r / 16, nb = r % 16;
                p0_fold_item(KIN(16) + (size_t)l * D * 2304, (bf16*)(F.ws + WS_WIN + (size_t)l * WIN_SZ), 32 * nb, 32 * kb, scr, F.lane); continue; }
            r -= I_FOLD;
            { const int kb = r / 32, nb = r % 32;
                p0_transpose_item(KIN(17) + (size_t)l * D * D, D, (bf16*)(F.ws + WS_WOUT + (size_t)l * WOUT_SZ), D, 32 * nb, 32 * nb, 64 * kb, scr, F.lane); continue; }
        }
        r -= I_W;
        if (r < I_TW) { if (r < 1024) p0_twiddle_row((bf16*)(F.ws + WS_T1024), 1024, r, F.lane); else p0_twiddle_row((bf16*)(F.ws + WS_T256), 256, r - 1024, F.lane); continue; }
        r -= I_TW;
        p0_cache_item(F, r, F.lane);
    }
}
__device__ __forceinline__ void p0b_modtables(Frame& F) {
    const float* mp = (const float*)(F.ws + WS_MODP); float* mt = (float*)(F.ws + WS_MODT);
    for (int idx = blockIdx.x * 512 + F.tid; idx < 2 * 3 * 5 * 1024; idx += F.G * 512) {
        const int col = idx & 1023, c = (idx >> 10) % 5, lk = idx / 5120, k = lk % 3, l = lk / 3;
        float m[3];
#pragma unroll
        for (int j = 0; j < 3; ++j) { const int comp = 3 * k + j; float s = KIN(8)[l * 9216 + comp * 1024 + col];
#pragma unroll
            for (int ks = 0; ks < 16; ++ks) s += mp[((size_t)((ks * 2 + l) * 5 + c)) * 9216 + comp * 1024 + col];
            m[j] = s; }
        const float nw = KIN(9 + k)[l * 1024 + col];
        mt[idx] = nw * (1.0f + m[1]); mt[30720 + idx] = m[0]; mt[61440 + idx] = m[2] * (k == 1 ? 1.0f : 0.5f);
    }
}
__device__ __forceinline__ const float* mod_tab(Frame& F, int which, int l, int k) { return (const float*)(F.ws + WS_MODT) + which * 30720 + (l * 3 + k) * 5120; }

__device__ __forceinline__ void norm_phase(Frame& F, const float* x0, const float* x1, const float* At, const float* St) {
    bf16* H = (bf16*)(F.ws + WS_H);
    const int gw = blockIdx.x * NWAVES + F.wave, NGW = F.G * NWAVES;
    for (int m = gw; m < M; m += NGW) {
        const float* xr = (m < MC ? x0 : x1) + (size_t)m * D; const int cond = m < MC ? 0 : 1 + ((m - MC) >> 10);
        f32x4 v[4]; float s = 0.f;
#pragma unroll
        for (int j = 0; j < 4; ++j) { v[j] = *(const f32x4*)(xr + 4 * F.lane + 256 * j); s += (v[j].x * v[j].x + v[j].y * v[j].y) + (v[j].z * v[j].z + v[j].w * v[j].w); }
#pragma unroll
        for (int o = 1; o < 64; o <<= 1) s += __shfl_xor(s, o);
        const float r = 1.0f / sqrtf(s * (1.0f / D) + 1e-6f);
#pragma unroll
        for (int j = 0; j < 4; ++j) { const f32x4 a = *(const f32x4*)(At + cond * 1024 + 4 * F.lane + 256 * j), sh = *(const f32x4*)(St + cond * 1024 + 4 * F.lane + 256 * j);
            const f32x4 h = v[j] * r * a + sh; u32x2 w; w.x = pk2(h.x, h.y); w.y = pk2(h.z, h.w);
            *(u32x2*)(H + (size_t)m * D + 4 * F.lane + 256 * j) = w; }
    }
}

struct ChunkInfo { int L, rowbase, cs, cg0, seq; bool lat; };
__device__ __forceinline__ ChunkInfo chunk_info(int chunk) {
    ChunkInfo c;
    if (chunk < 256) { c.lat = false; c.seq = chunk >> 3; c.cs = chunk & 7; c.L = 256; c.rowbase = c.seq * 256; c.cg0 = c.seq * 8; }
    else { const int cc = chunk - 256; c.lat = true; c.seq = cc >> 5; c.cs = cc & 31; c.L = 1024; c.rowbase = MC + c.seq * 1024; c.cg0 = 256 + c.seq * 32; }
    return c;
}
__device__ __forceinline__ void prep_hgrn(Frame& F, int l, const ChunkInfo& ci) {
    const bf16* Z = (const bf16*)(F.ws + WS_Z);
    const int dr = F.tid >> 8, ch = F.tid & 255;
    float lb = 0.f;
    if (l == 1) { const float a0 = KIN(18)[(0 * 2 + dr) * 256 + ch], a1 = KIN(18)[(1 * 2 + dr) * 256 + ch]; lb = 1.0f / (1.0f + expf_fast(a0 - a1)); }
    const float lbf = fmaxf(lb, 1e-30f), oml = 1.0f - lb;
    float bb[32], kv[32];
    float b = 0.f;
#pragma unroll
    for (int i = 0; i < 32; ++i) { const int tau = 32 * ci.cs + i, t = dr ? ci.L - 1 - tau : tau; const bf16* zr = Z + (size_t)(ci.rowbase + t) * ZW;
        const float zf = fmaxf(bf2f(zr[(dr ? ZC_HFB : ZC_HFF) + ch]), -60.0f);
        const float e = expf_fast(-zf), sig = __builtin_amdgcn_rcpf(1.0f + e), sneg = e * sig;
        const float f = lbf + oml * sig; b += __builtin_amdgcn_logf(f) * 0.6931471805599453f;
        bb[i] = b; kv[i] = oml * sneg; }
    const float bref = bb[15], bT = bb[31];
    bf16* QR = (bf16*)(F.ws + WS_QR); bf16* KR = (bf16*)(F.ws + WS_KR); bf16* QINP = (bf16*)(F.ws + WS_QINP);
    const int chp = (ch & ~63) | swap23(ch & 63);
#pragma unroll
    for (int i = 0; i < 32; ++i) { const int tau = 32 * ci.cs + i, t = dr ? ci.L - 1 - tau : tau;
        const float qv = bf2f(Z[(size_t)(ci.rowbase + t) * ZW + ZC_HQ + ch]) * 0.125f;
        const size_t p = ((size_t)(ci.rowbase + tau) * 2 + dr) * 256;
        QR[p + ch] = (bf16)f2bf(qv * expf_fast(fminf(bb[i] - bref, 80.f)));
        KR[p + ch] = (bf16)f2bf(kv[i] * expf_fast(fminf(bref - bb[i], 80.f)));
        QINP[p + chp] = (bf16)f2bf(qv * expf_fast(bb[i])); }
    const int cg = ci.cg0 + ci.cs;
    const size_t tb = (((size_t)cg * 2 + dr) * 256 + ch) * 32;
    bf16* KOUTT = (bf16*)(F.ws + WS_KOUTT) + tb; bf16* VT = (bf16*)(F.ws + WS_VT) + tb;
#pragma unroll
    for (int j = 0; j < 4; ++j) { float a[8];
#pragma unroll
        for (int e = 0; e < 8; ++e) { const int i = swap23(8 * j + e); a[e] = kv[i] * expf_fast(bT - bb[i]); }
        *(GAS bf16x8*)(KOUTT + 8 * j) = pack8(a); }
#pragma unroll
    for (int j = 0; j < 4; ++j) { unsigned vv[8];
#pragma unroll
        for (int e = 0; e < 8; ++e) { const int tau = 32 * ci.cs + swap23(8 * j + e), t = dr ? ci.L - 1 - tau : tau; vv[e] = Z[(size_t)(ci.rowbase + t) * ZW + ZC_HI + ch]; }
        v4u w; w.x = vv[0] | (vv[1] << 16); w.y = vv[2] | (vv[3] << 16); w.z = vv[4] | (vv[5] << 16); w.w = vv[6] | (vv[7] << 16);
        *(GAS v4u*)(VT + 8 * j) = w; }
    ((float*)(F.ws + WS_EB))[((size_t)cg * 2 + dr) * 256 + ch] = expf_fast(bT);
}
__device__ __forceinline__ void head_norm_rope(float (&x)[32], const float* nw, bool rope, int pos, float scale) {
    float ss = 0.f;
#pragma unroll
    for (int j = 0; j < 32; ++j) ss += x[j] * x[j];
    ss += __shfl_xor(ss, 1);
    const float r = 1.0f / sqrtf(ss * (1.0f / 64.0f) + 1e-6f);
#pragma unroll
    for (int j = 0; j < 32; ++j) x[j] = x[j] * r * nw[j];
    if (rope) {
#pragma unroll
        for (int j = 0; j < 16; ++j) { const float inv = ex2(-(float)j * (13.287712379549449f / 16.0f));
            const float rev = (float)pos * inv * 0.15915494309189535f; const float c = __builtin_amdgcn_cosf(rev), s = __builtin_amdgcn_sinf(rev);
            const float a = x[j], bq = x[j + 16]; x[j] = a * c - bq * s; x[j + 16] = bq * c + a * s; }
    }
#pragma unroll
    for (int j = 0; j < 32; ++j) x[j] *= scale;
}
__device__ __forceinline__ void load32(const bf16* p, float (&x)[32]) {
#pragma unroll
    for (int j = 0; j < 4; ++j) { const v4u w = *(const GAS v4u*)(p + 8 * j);
        x[8 * j + 0] = bf2f(w.x & 0xffffu); x[8 * j + 1] = bf2f(w.x >> 16); x[8 * j + 2] = bf2f(w.y & 0xffffu); x[8 * j + 3] = bf2f(w.y >> 16);
        x[8 * j + 4] = bf2f(w.z & 0xffffu); x[8 * j + 5] = bf2f(w.z >> 16); x[8 * j + 6] = bf2f(w.w & 0xffffu); x[8 * j + 7] = bf2f(w.w >> 16); }
}
__device__ __forceinline__ void store32(bf16* p, const float (&x)[32]) {
#pragma unroll
    for (int j = 0; j < 4; ++j) *(GAS bf16x8*)(p + 8 * j) = pack8(&x[8 * j]);
}
__device__ __forceinline__ void prep_misc(Frame& F, int l, const ChunkInfo& ci) {
    bf16* Z = (bf16*)(F.ws + WS_Z);
    const int row0 = ci.rowbase + 32 * ci.cs, cg = ci.cg0 + ci.cs;
    { const int col = F.tid; unsigned vv[32];
#pragma unroll
      for (int i = 0; i < 32; ++i) vv[i] = Z[(size_t)(row0 + i) * ZW + ZC_Y + col];
      bf16* YT = (bf16*)(F.ws + WS_YT) + (ci.lat ? (size_t)MC * 512 + (size_t)ci.seq * 512 * 1024 : (size_t)ci.seq * 512 * 256) + (size_t)col * ci.L + 32 * ci.cs;
#pragma unroll
      for (int j = 0; j < 4; ++j) { v4u w; w.x = vv[8 * j] | (vv[8 * j + 1] << 16); w.y = vv[8 * j + 2] | (vv[8 * j + 3] << 16); w.z = vv[8 * j + 4] | (vv[8 * j + 5] << 16); w.w = vv[8 * j + 6] | (vv[8 * j + 7] << 16);
          *(GAS v4u*)(YT + 8 * j) = w; } }
    { const int i = F.tid >> 4, hh = F.tid & 15, hq = hh >> 1, half = hh & 1, t = 32 * ci.cs + i;
      bf16* p = Z + (size_t)(row0 + i) * ZW + ZC_AQ + hq * 64 + half * 32; float x[32]; load32(p, x);
      head_norm_rope(x, KIN(20) + l * 64 + half * 32, ci.lat, half ? (t & 63) : (t >> 6), QSCALE); store32(p, x); }
    if (F.tid < 128) { const int i = F.tid >> 2, hh = F.tid & 3, kvh = hh >> 1, half = hh & 1, t = 32 * ci.cs + i;
      bf16* p = Z + (size_t)(row0 + i) * ZW + ZC_AK + kvh * 64 + half * 32; float x[32]; load32(p, x);
      head_norm_rope(x, KIN(21) + l * 64 + half * 32, ci.lat, half ? (t & 63) : (t >> 6), 1.0f); store32(p, x);
      if (!ci.lat) { float* o = F.out + OUT_CK + (((size_t)ci.seq * 2 + l) * 256 + t) * 128 + kvh * 64 + half * 32;
#pragma unroll
          for (int j = 0; j < 8; ++j) *(f32x4*)(o + 4 * j) = (f32x4){x[4 * j], x[4 * j + 1], x[4 * j + 2], x[4 * j + 3]}; } }
    else if (F.tid < 256) { const int vc = F.tid - 128; unsigned vv[32];
#pragma unroll
      for (int i = 0; i < 32; ++i) vv[i] = Z[(size_t)(row0 + i) * ZW + ZC_AV + vc];
      bf16* VTP = (bf16*)(F.ws + WS_VTP) + ((size_t)cg * 128 + vc) * 32;
#pragma unroll
      for (int j = 0; j < 4; ++j) { v4u w;
          w.x = vv[swap23(8 * j + 0)] | (vv[swap23(8 * j + 1)] << 16); w.y = vv[swap23(8 * j + 2)] | (vv[swap23(8 * j + 3)] << 16);
          w.z = vv[swap23(8 * j + 4)] | (vv[swap23(8 * j + 5)] << 16); w.w = vv[swap23(8 * j + 6)] | (vv[swap23(8 * j + 7)] << 16);
          *(GAS v4u*)(VTP + 8 * j) = w; }
      if (!ci.lat) {
#pragma unroll
          for (int i = 0; i < 32; ++i) F.out[OUT_CV + (((size_t)ci.seq * 2 + l) * 256 + 32 * ci.cs + i) * 128 + vc] = bf2f(vv[i]); } }
}
__device__ __forceinline__ void prep_phase(Frame& F, int l) {
    for (int it = blockIdx.x; it < 2 * NCHUNK; it += F.G) {
        const ChunkInfo ci = chunk_info(it >> 1);
        if (it & 1) prep_misc(F, l, ci); else prep_hgrn(F, l, ci);
    }
}

#define MFMA32(a, b, c) __builtin_amdgcn_mfma_f32_32x32x16_bf16((a), (b), (c), 0, 0, 0)
__device__ __forceinline__ bf16x8 ld8(const bf16* p) { return *(const GAS bf16x8*)p; }
__device__ __forceinline__ bf16x8 cvt8(const f32x16& v, int s) { v4u w; w.x = pk2(v[8 * s], v[8 * s + 1]); w.y = pk2(v[8 * s + 2], v[8 * s + 3]); w.z = pk2(v[8 * s + 4], v[8 * s + 5]); w.w = pk2(v[8 * s + 6], v[8 * s + 7]); return __builtin_bit_cast(bf16x8, w); }
__device__ __forceinline__ f32x16 zero16() { f32x16 z; for (int i = 0; i < 16; ++i) z[i] = 0.f; return z; }

__device__ __forceinline__ void fourier_unit(Frame& F, bool lat, int seq, int g, int pb) {
    const int L = lat ? 1024 : 256, rowbase = lat ? MC + seq * 1024 : seq * 256, r = F.lane & 31, h = F.lane >> 5;
    const bf16* YT = (const bf16*)(F.ws + WS_YT) + (lat ? (size_t)MC * 512 + (size_t)seq * 512 * 1024 : (size_t)seq * 512 * 256);
    const bf16* T = (const bf16*)(F.ws + (lat ? WS_T1024 : WS_T256));
    f32x16 acc[2][2]; acc[0][0] = zero16(); acc[0][1] = zero16(); acc[1][0] = zero16(); acc[1][1] = zero16();
    const bf16* ya = YT + (size_t)(g * 64 + r) * L + 8 * h;
    const bf16* tb = T + (size_t)(pb * 64 + r) * 2 * L + 8 * h;
    const int nks = 2 * L / 16;
#pragma unroll 4
    for (int ks = 0; ks < nks; ++ks) { const int k0 = 16 * ks, comp = k0 >= L, t0 = k0 - comp * L;
        const bf16x8 a0 = ld8(ya + (size_t)(comp * 256) * L + t0), a1 = ld8(ya + (size_t)(comp * 256 + 32) * L + t0);
        const bf16x8 b0 = ld8(tb + k0), b1 = ld8(tb + (size_t)32 * 2 * L + k0);
        acc[0][0] = MFMA32(a0, b0, acc[0][0]); acc[0][1] = MFMA32(a0, b1, acc[0][1]); acc[1][0] = MFMA32(a1, b0, acc[1][0]); acc[1][1] = MFMA32(a1, b1, acc[1][1]); }
    bf16* MX = (bf16*)(F.ws + WS_MIX);
#pragma unroll
    for (int ci = 0; ci < 2; ++ci)
#pragma unroll
        for (int pi = 0; pi < 2; ++pi) { bf16* o = MX + (size_t)(rowbase + pb * 64 + 32 * pi + r) * 1024 + g * 64 + 32 * ci + 4 * h;
#pragma unroll
            for (int gq = 0; gq < 4; ++gq) { u32x2 w; w.x = pk2(acc[ci][pi][4 * gq], acc[ci][pi][4 * gq + 1]); w.y = pk2(acc[ci][pi][4 * gq + 2], acc[ci][pi][4 * gq + 3]); *(GAS u32x2*)(o + 8 * gq) = w; } }
}

__device__ __forceinline__ void attn_unit(Frame& F, int l, bool lat, int seq, int hq, int qb) {
    const int L = lat ? 1024 : 256, rowbase = lat ? MC + seq * 1024 : seq * 256, r = F.lane & 31, h = F.lane >> 5, kvh = hq >> 2;
    const int cg0 = lat ? 256 + seq * 32 : seq * 8;
    const bf16* Z = (const bf16*)(F.ws + WS_Z);
    bf16x8 qf[4];
#pragma unroll
    for (int kk = 0; kk < 4; ++kk) qf[kk] = ld8(Z + (size_t)(rowbase + 32 * qb + r) * ZW + ZC_AQ + hq * 64 + 16 * kk + 8 * h);
    float m = KIN(22)[l * 8 + hq] * LOG2E, lsum = 1.0f;
    f32x16 ot[2]; ot[0] = zero16(); ot[1] = zero16();
    const int kb_lo = lat ? (qb - 4 < 0 ? 0 : qb - 4) : 0, kb_hi = lat ? (qb + 4 > 31 ? 31 : qb + 4) : 7;
    const int nloc = kb_hi - kb_lo + 1, ntile = nloc + (lat ? 16 : 0);
    const bf16* VTP = (const bf16*)(F.ws + WS_VTP);
    const bf16* KC = (const bf16*)(F.ws + WS_KC) + (((size_t)(seq * 2 + l) * 2 + kvh) * 512) * 64;
    const bf16* VCT = (const bf16*)(F.ws + WS_VCT) + (((size_t)(seq * 2 + l) * 2 + kvh) * 64) * 512;
    for (int ti = 0; ti < ntile; ++ti) {
        const bool loc = ti < nloc; const int kb = loc ? kb_lo + ti : ti - nloc;
        const bf16* kp = loc ? Z + (size_t)(rowbase + 32 * kb + r) * ZW + ZC_AK + kvh * 64 + 8 * h : KC + (size_t)(32 * kb + r) * 64 + 8 * h;
        const bf16* vp = loc ? VTP + ((size_t)(cg0 + kb) * 128 + kvh * 64 + r) * 32 + 8 * h : VCT + (size_t)r * 512 + 32 * kb + 8 * h;
        const size_t vstep = loc ? 32 * 32 : 32 * 512;
        bf16x8 kf[4], vf[2][2];
#pragma unroll
        for (int kk = 0; kk < 4; ++kk) kf[kk] = ld8(kp + 16 * kk);
#pragma unroll
        for (int tv = 0; tv < 2; ++tv)
#pragma unroll
            for (int s = 0; s < 2; ++s) vf[tv][s] = ld8(vp + tv * vstep + 16 * s);
        f32x16 st = zero16();
#pragma unroll
        for (int kk = 0; kk < 4; ++kk) st = MFMA32(kf[kk], qf[kk], st);
        if (lat && loc) { const int dq = 32 * qb + r - 32 * kb - 4 * h;
#pragma unroll
            for (int reg = 0; reg < 16; ++reg) { const int d = dq - ((reg & 3) + 8 * (reg >> 2)); if (d > 128 || d < -128) st[reg] = -INFINITY; } }
        float mx = st[0];
#pragma unroll
        for (int reg = 1; reg < 16; ++reg) mx = fmaxf(mx, st[reg]);
        mx = fmaxf(mx, __shfl_xor(mx, 32));
        const float mn = fmaxf(m, mx), alpha = ex2(m - mn); m = mn;
        float rs = 0.f;
#pragma unroll
        for (int reg = 0; reg < 16; ++reg) { st[reg] = ex2(st[reg] - mn); rs += st[reg]; }
        rs += __shfl_xor(rs, 32);
        lsum = lsum * alpha + rs;
#pragma unroll
        for (int reg = 0; reg < 16; ++reg) { ot[0][reg] *= alpha; ot[1][reg] *= alpha; }
        const bf16x8 p0 = cvt8(st, 0), p1 = cvt8(st, 1);
        ot[0] = MFMA32(vf[0][0], p0, ot[0]); ot[0] = MFMA32(vf[0][1], p1, ot[0]);
        ot[1] = MFMA32(vf[1][0], p0, ot[1]); ot[1] = MFMA32(vf[1][1], p1, ot[1]);
    }
    const float inv = 1.0f / lsum;
    bf16* o = (bf16*)(F.ws + WS_MIX) + (size_t)(rowbase + 32 * qb + r) * 1024 + 512 + hq * 64 + 4 * h;
#pragma unroll
    for (int tv = 0; tv < 2; ++tv)
#pragma unroll
        for (int gq = 0; gq < 4; ++gq) { u32x2 w; w.x = pk2(ot[tv][4 * gq] * inv, ot[tv][4 * gq + 1] * inv); w.y = pk2(ot[tv][4 * gq + 2] * inv, ot[tv][4 * gq + 3] * inv);
            *(GAS u32x2*)(o + 32 * tv + 8 * gq) = w; }
}

__device__ __forceinline__ void hgrn_unit(Frame& F, int l, bool lat, int seq, int hp) {
    const int L = lat ? 1024 : 256, rowbase = lat ? MC + seq * 1024 : seq * 256, r = F.lane & 31, h = F.lane >> 5;
    const int cg0 = lat ? 256 + seq * 32 : seq * 8, nch = L / 32;
    const int hd = hp * 2 + (F.wave >> 2), dr = (F.wave >> 1) & 1, dvh = F.wave & 1;
    const bf16* QR = (const bf16*)(F.ws + WS_QR); const bf16* KR = (const bf16*)(F.ws + WS_KR); const bf16* QINP = (const bf16*)(F.ws + WS_QINP);
    const bf16* KOUTT = (const bf16*)(F.ws + WS_KOUTT); const bf16* VT = (const bf16*)(F.ws + WS_VT); const float* EB = (const float*)(F.ws + WS_EB);
    bf16* OSC = (bf16*)(F.ws + WS_OSC);
    f32x16 S[2];
    if (lat) { const float* s0 = KIN(5) + ((((size_t)seq * 2 + l) * 2 + dr) * 4 + hd) * 4096;
#pragma unroll
        for (int t = 0; t < 2; ++t)
#pragma unroll
            for (int reg = 0; reg < 16; ++reg) S[t][reg] = s0[(32 * t + krow(reg, h)) * 64 + 32 * dvh + r]; }
    else { S[0] = zero16(); S[1] = zero16(); }
    for (int cs = 0; cs < nch; ++cs) {
        const size_t pb = ((size_t)(rowbase + 32 * cs + r) * 2 + dr) * 256 + hd * 64 + 8 * h;
        const size_t cb = ((size_t)(cg0 + cs) * 2 + dr) * 256 + hd * 64;
        bf16x8 kr[4], qr[4], qin[4], kot[2][2], vt[2]; f32x4 eb[2][4];
#pragma unroll
        for (int kk = 0; kk < 4; ++kk) { kr[kk] = ld8(KR + pb + 16 * kk); qr[kk] = ld8(QR + pb + 16 * kk); qin[kk] = ld8(QINP + pb + 16 * kk); }
#pragma unroll
        for (int s = 0; s < 2; ++s) { vt[s] = ld8(VT + (cb + 32 * dvh + r) * 32 + 16 * s + 8 * h);
#pragma unroll
            for (int t = 0; t < 2; ++t) kot[t][s] = ld8(KOUTT + (cb + 32 * t + r) * 32 + 16 * s + 8 * h); }
#pragma unroll
        for (int t = 0; t < 2; ++t)
#pragma unroll
            for (int gq = 0; gq < 4; ++gq) eb[t][gq] = *(const f32x4*)(EB + cb + 32 * t + 8 * gq + 4 * h);
        f32x16 a1 = zero16();
#pragma unroll
        for (int kk = 0; kk < 4; ++kk) a1 = MFMA32(kr[kk], qr[kk], a1);
#pragma unroll
        for (int reg = 0; reg < 16; ++reg) if (krow(reg, h) > r) a1[reg] = 0.f;
        f32x16 ot = zero16();
        ot = MFMA32(vt[0], cvt8(a1, 0), ot); ot = MFMA32(vt[1], cvt8(a1, 1), ot);
#pragma unroll
        for (int t = 0; t < 2; ++t)
#pragma unroll
            for (int s = 0; s < 2; ++s) ot = MFMA32(cvt8(S[t], s), qin[2 * t + s], ot);
#pragma unroll
        for (int t = 0; t < 2; ++t) {
#pragma unroll
            for (int reg = 0; reg < 16; ++reg) S[t][reg] *= eb[t][reg >> 2][reg & 3];
            S[t] = MFMA32(kot[t][0], vt[0], S[t]); S[t] = MFMA32(kot[t][1], vt[1], S[t]); }
        const int tau = 32 * cs + r, tt = dr ? L - 1 - tau : tau;
        bf16* o = OSC + ((size_t)(rowbase + tt) * 2 + dr) * 256 + hd * 64 + 32 * dvh + 4 * h;
#pragma unroll
        for (int gq = 0; gq < 4; ++gq) { u32x2 w; w.x = pk2(ot[4 * gq], ot[4 * gq + 1]); w.y = pk2(ot[4 * gq + 2], ot[4 * gq + 3]); *(GAS u32x2*)(o + 8 * gq) = w; }
    }
    if (!lat) { float* so = F.out + OUT_ST + ((((size_t)seq * 2 + l) * 2 + dr) * 4 + hd) * 4096;
#pragma unroll
        for (int t = 0; t < 2; ++t)
#pragma unroll
            for (int reg = 0; reg < 16; ++reg) so[(32 * t + krow(reg, h)) * 64 + 32 * dvh + r] = S[t][reg]; }
    VM_WAIT(); __syncthreads();
    const bf16* Z = (const bf16*)(F.ws + WS_Z); bf16* MX = (bf16*)(F.ws + WS_MIX);
    for (int idx = F.tid; idx < L * 8; idx += 512) { const int q4 = idx & 3, hh = (idx >> 2) & 1, t = idx >> 3, hdc = hp * 2 + hh, row = rowbase + t;
        float of[16], ob[16], gg[16];
        { const bf16* p = OSC + ((size_t)row * 2 + 0) * 256 + hdc * 64 + 16 * q4; const v4u w0 = *(const GAS v4u*)p, w1 = *(const GAS v4u*)(p + 8);
          const unsigned ww[8] = {w0.x, w0.y, w0.z, w0.w, w1.x, w1.y, w1.z, w1.w};
#pragma unroll
          for (int j = 0; j < 8; ++j) { of[2 * j] = bf2f(ww[j] & 0xffffu); of[2 * j + 1] = bf2f(ww[j] >> 16); } }
        { const bf16* p = OSC + ((size_t)row * 2 + 1) * 256 + hdc * 64 + 16 * q4; const v4u w0 = *(const GAS v4u*)p, w1 = *(const GAS v4u*)(p + 8);
          const unsigned ww[8] = {w0.x, w0.y, w0.z, w0.w, w1.x, w1.y, w1.z, w1.w};
#pragma unroll
          for (int j = 0; j < 8; ++j) { ob[2 * j] = bf2f(ww[j] & 0xffffu); ob[2 * j + 1] = bf2f(ww[j] >> 16); } }
        { const bf16* p = Z + (size_t)row * ZW + ZC_HG + hdc * 64 + 16 * q4; const v4u w0 = *(const GAS v4u*)p, w1 = *(const GAS v4u*)(p + 8);
          const unsigned ww[8] = {w0.x, w0.y, w0.z, w0.w, w1.x, w1.y, w1.z, w1.w};
#pragma unroll
          for (int j = 0; j < 8; ++j) { gg[2 * j] = bf2f(ww[j] & 0xffffu); gg[2 * j + 1] = bf2f(ww[j] >> 16); } }
        float ss = 0.f;
#pragma unroll
        for (int j = 0; j < 16; ++j) { of[j] += ob[j]; ss += of[j] * of[j]; }
        ss += __shfl_xor(ss, 1); ss += __shfl_xor(ss, 2);
        const float rn = 1.0f / sqrtf(ss * (1.0f / 64.0f) + 1e-6f);
        const float* nw = KIN(19) + l * 256 + hdc * 64 + 16 * q4;
        float res[16];
#pragma unroll
        for (int j = 0; j < 16; ++j) { const float g = gg[j]; res[j] = of[j] * rn * nw[j] * (g * __builtin_amdgcn_rcpf(1.0f + expf_fast(-g))); }
        bf16* o = MX + (size_t)row * 1024 + 256 + hdc * 64 + 16 * q4;
        *(GAS bf16x8*)o = pack8(res); *(GAS bf16x8*)(o + 8) = pack8(res + 8);
    }
}
constexpr int MIX_ITEMS = 8 + 32 + 64 + 128 + 256 + 64;
__device__ __forceinline__ void mix_phase(Frame& F, int l) {
    gu32* head = F.ctl + CW_Q + 64 * l;
    for (;;) {
        if (F.tid == 0) F.MISC[16] = __hip_atomic_fetch_add(head, 1u, RLX_AGENT);
        __syncthreads();
        const int it = (int)F.MISC[16];
        __syncthreads();
        if (it >= MIX_ITEMS) break;
        int j = it;
        if (j < 8) { hgrn_unit(F, l, true, j >> 1, j & 1); continue; } j -= 8;
        if (j < 32) { const int wu = j * 8 + F.wave; fourier_unit(F, true, wu >> 6, (wu >> 4) & 3, wu & 15); continue; } j -= 32;
        if (j < 64) { hgrn_unit(F, l, false, j >> 1, j & 1); continue; } j -= 64;
        if (j < 128) { attn_unit(F, l, true, j >> 5, ((j >> 4) & 1) * 4 + (F.wave & 3), (j & 15) * 2 + (F.wave >> 2)); continue; } j -= 128;
        if (j < 256) { attn_unit(F, l, false, j >> 3, ((j >> 2) & 1) * 4 + (F.wave & 3), (j & 3) * 2 + (F.wave >> 2)); continue; } j -= 256;
        { const int wu = j * 8 + F.wave; fourier_unit(F, false, wu >> 4, (wu >> 2) & 3, wu & 3); }
    }
}

#ifndef PH
#define PH 0xffff
#endif
struct Args { const float* in[23]; float* out; unsigned char* ws; };
__global__ void __launch_bounds__(NWAVES * 64, 2) fwd_kernel(Args args) {
    extern __shared__ __attribute__((aligned(16))) unsigned char lds[];
    Frame F;
    F.lds = (LAS unsigned char*)lds; F.MISC = (volatile LAS unsigned*)(F.lds + MISC_OFF);
    F.tid = threadIdx.x; F.lane = F.tid & 63; F.wave = __builtin_amdgcn_readfirstlane(F.tid >> 6); F.G = gridDim.x;
    F.out = args.out; F.ws = args.ws; F.ctl = (gu32*)(args.ws + WS_CTL);
    for (int u = F.tid; u < (LDS_BYTES - LDSCTL_OFF) / 4; u += NWAVES * 64) ((LAS unsigned*)(F.lds + LDSCTL_OFF))[u] = 0u;
    __syncthreads();
    XcdBarrier bar = xcd_barrier_post((unsigned*)(F.ctl + CW_BAR), F.MISC + 8);
#define GRID_BAR() do { xcd_barrier(bar); TID_REFRESH(); } while (0)
#define TID_REFRESH() do { int t_ = threadIdx.x; asm volatile("" : "+v"(t_)); F.tid = t_; F.lane = t_ & 63; F.wave = __builtin_amdgcn_readfirstlane(t_ >> 6); } while (0)
    bf16* H = (bf16*)(F.ws + WS_H); bf16* ACT = (bf16*)(F.ws + WS_ACT); bf16* ZB = (bf16*)(F.ws + WS_Z); bf16* MX = (bf16*)(F.ws + WS_MIX);
    float* X = F.out;

#if PH & 1
    p0_prologue(F); GRID_BAR();
#endif
#if PH & 2
    p0b_modtables(F); GRID_BAR();
#endif
#pragma nounroll
    for (int step = 0; step < 6; ++step) {
        const int l = step / 3, part = step - 3 * l;
        if (part != 1) {
            const int f = part >> 1, k = 2 * f; const bool first = step == 0;
            const float* xs0 = first ? KIN(0) : X; const float* xs1 = first ? KIN(1) - (size_t)MC * D : X;
#if PH & 4
            norm_phase(F, xs0, xs1, mod_tab(F, 0, l, k), mod_tab(F, 1, l, k)); GRID_BAR();
#endif
#if PH & 8
            { pg8::Gemm g{H, (const bf16*)(F.ws + WS_WGU + (size_t)(l * 2 + f) * WGU_SZ), M, NGU, D}; pg8::StaticOrder S; S.init(M, NGU, F.G, (int)blockIdx.x);
              pg8::EpiSwiglu E{ACT, FF}; pg8::gemm_phase<pg8::EpiSwiglu, pg8::StaticOrder, true, true>(F.lds, g, S, E, F.tid); } GRID_BAR();
#endif
#if PH & 16
            { pg8::Gemm g{ACT, (const bf16*)(F.ws + WS_WDN + (size_t)(l * 2 + f) * WDN_SZ), M, D, FF}; pg8::StaticOrder S; S.init(M, D, F.G, (int)blockIdx.x);
              pg8::EpiRes E{xs0, xs1, X, mod_tab(F, 2, l, k)}; pg8::gemm_phase<pg8::EpiRes, pg8::StaticOrder, true, true>(F.lds, g, S, E, F.tid); }
            if (step != 5) GRID_BAR();
#endif
        } else {
#if PH & 4
            norm_phase(F, X, X, mod_tab(F, 0, l, 1), mod_tab(F, 1, l, 1)); GRID_BAR();
#endif
#if PH & 32
            { pg8::Gemm g{H, (const bf16*)(F.ws + WS_WIN + (size_t)l * WIN_SZ), M, ZW, D}; pg8::StaticOrder S; S.init(M, ZW, F.G, (int)blockIdx.x);
              pg8::EpiBf16<0> E{ZB, ZW, nullptr, 0, 0, 1.f}; pg8::gemm_phase<pg8::EpiBf16<0>, pg8::StaticOrder, true, true>(F.lds, g, S, E, F.tid); } GRID_BAR();
#endif
#if PH & 64
            prep_phase(F, l); GRID_BAR();
#endif
#if PH & 128
            mix_phase(F, l); GRID_BAR();
#endif
#if PH & 256
            { pg8::Gemm g{MX, (const bf16*)(F.ws + WS_WOUT + (size_t)l * WOUT_SZ), M, D, D}; pg8::StaticOrder S; S.init(M, D, F.G, (int)blockIdx.x);
              pg8::EpiRes E{X, X, X, mod_tab(F, 2, l, 1)}; pg8::gemm_phase<pg8::EpiRes, pg8::StaticOrder, true, true>(F.lds, g, S, E, F.tid); } GRID_BAR();
#endif
        }
    }
}

extern "C" void kernel_launch(void* const* d_in, const int* in_sizes, int n_in, void* d_out, int out_size, void* d_ws, size_t ws_size, hipStream_t stream) {
    static int grid = 0;
    if (grid == 0) {
        if (n_in != 23 || out_size != OUT_TOTAL || ws_size < WS_END) { fprintf(stderr, "kernel_launch: unexpected shapes (n_in %d, out %d, ws %zu)\n", n_in, out_size, ws_size); grid = -1; return; }
        int dev = 0, cus = 0;
        if (hipGetDevice(&dev) != hipSuccess || hipDeviceGetAttribute(&cus, hipDeviceAttributeMultiprocessorCount, dev) != hipSuccess) { grid = -1; return; }
        if (hipFuncSetAttribute((const void*)fwd_kernel, hipFuncAttributeMaxDynamicSharedMemorySize, LDS_BYTES) != hipSuccess) { fprintf(stderr, "kernel_launch: hipFuncSetAttribute failed\n"); grid = -1; return; }
        (void)hipGetLastError();
        grid = cus;
    }
    if (grid < 0) return;
    if (hipMemsetAsync((char*)d_ws + WS_CTL, 0, CTL_ZERO_BYTES, stream) != hipSuccess) return;
    Args a{};
    for (int i = 0; i < 23; ++i) a.in[i] = (const float*)d_in[i];
    a.out = (float*)d_out; a.ws = (unsigned char*)d_ws;
    hipLaunchKernelGGL(fwd_kernel, dim3(grid), dim3(NWAVES * 64), LDS_BYTES, stream, a);
}
```

```cpp
#include <hip/hip_runtime.h>
#include <cstdio>
#include <cstdint>
namespace pg8 {
#define PG8_LAS __attribute__((address_space(3)))
typedef unsigned short bf16_t;
typedef short bf16x8 __attribute__((ext_vector_type(8)));
typedef float f32x4 __attribute__((ext_vector_type(4)));
typedef unsigned u32x4 __attribute__((ext_vector_type(4)));
constexpr int BM = 256, BK = 64, HALF = 128, HTB = HALF * BK * 2  , STAGE_BYTES = 8 * HTB, NXCD = 8, WGM = 8;

__host__ __device__ __forceinline__ int lds_byte(int r, int c) { const int st = (r >> 4) * 2 + (c >> 5), rr = r & 15, cc = c & 31, ob = rr * 64 + cc * 2; return st * 1024 + (ob ^ (((ob >> 9) & 1) << 5)); }
__host__ __device__ __forceinline__ void stage_rc(int b, int& R, int& C) { const int st = b / 1024, sb = b % 1024, swz = sb ^ (((sb >> 9) & 1) << 5); R = (st >> 1) * 16 + swz / 64; C = (st & 1) * 32 + (swz % 64) / 2; }
__host__ __device__ __forceinline__ int perm32(int rho) { const int n = rho >> 4, i = rho & 15; return 8 * (i >> 2) + 4 * n + (i & 3); }

struct Unit { int pm, pn; };
struct Gemm { const bf16_t* A; const bf16_t* Bt; int M, N, K; };

struct StaticOrder {
    int nM, nN, nwg, G, c;
    __host__ __device__ void init(int M, int N, int G_, int c_) { nM = M / BM; nN = N / BM; nwg = nM * nN; G = G_; c = c_; }
    __host__ __device__ bool next(int i, Unit& u) const {
        const long L = (long)i * G + c; if (L >= nwg) return false;
        int wgid = (int)L; { const int q = nwg / NXCD, r = nwg % NXCD, xcd = wgid % NXCD, off = wgid / NXCD; wgid = (xcd < r ? xcd * (q + 1) : r * (q + 1) + (xcd - r) * q) + off; }
        const int nig = WGM * nN, gid = wgid / nig, fm = gid * WGM, gsz = (nM - fm) < WGM ? (nM - fm) : WGM;
        u.pm = fm + ((wgid % nig) % gsz); u.pn = (wgid % nig) / gsz; return true;
    }
    __device__ __forceinline__ void a_ready(const Unit&) const {}
    __device__ __forceinline__ void done(const Unit&) const {}
};

__device__ __forceinline__ unsigned cvt_pk_bf16(float lo, float hi) { unsigned r; asm volatile("v_cvt_pk_bf16_f32 %0, %1, %2" : "=v"(r) : "v"(lo), "v"(hi)); return r; }
typedef float f32x2 __attribute__((ext_vector_type(2)));
__device__ __forceinline__ f32x2 gelu_pk(f32x2 v) {
    const f32x2 av = __builtin_elementwise_abs(v), d = av * 0.2316418882f + 1.0f;
    f32x2 t; t.x = __builtin_amdgcn_rcpf(d.x); t.y = __builtin_amdgcn_rcpf(d.y);
    f32x2 q = t * 0.5307027145f + (-0.7265760135f); q = q * t + 0.7107068705f; q = q * t + (-0.142248368f); q = q * t + 0.127414796f; q = q * t;
    const f32x2 s = (v * v) * (-0.72134752044f);
    f32x2 e; e.x = __builtin_amdgcn_exp2f(s.x); e.y = __builtin_amdgcn_exp2f(s.y);
    const f32x2 m = v * (q * e), r = v - m;
    f32x2 o; o.x = v.x < 0.f ? m.x : r.x; o.y = v.y < 0.f ? m.y : r.y; return o;
}

template <int ACT  > struct EpiBf16 {
    static constexpr bool PERM = true, AFTER_DRAIN = false; static_assert(ACT == 0 || ACT == 1, "EpiBf16: ACT is 0 (none) or 1 (gelu_pk)");
    bf16_t* O; int ldc; const float* bias; int split_cols; size_t split_stride; float scale0;
    __device__ __forceinline__ void operator()(const f32x4 (&acc)[2][2][4][2], const Unit& u, int wr, int wc, int fr, int fq) const {
        const int row0 = u.pm * BM + wr * 64 + fr; int colt = u.pn * BM; bf16_t* base = O;
        float sc = 1.f; if (split_cols) { const int t = colt / split_cols; base += (size_t)t * split_stride; colt -= t * split_cols; if (t == 0) sc = scale0; }
        const int col0 = colt + wc * 32 + 8 * fq, bcol0 = u.pn * BM + wc * 32 + 8 * fq;
        f32x4 bv[2][2];
#pragma unroll
        for (int bj = 0; bj < 2; ++bj)
#pragma unroll
            for (int n = 0; n < 2; ++n) bv[bj][n] = bias ? *(const f32x4*)(bias + bcol0 + bj * HALF + 4 * n) : (f32x4){0.f, 0.f, 0.f, 0.f};
#pragma unroll
        for (int ai = 0; ai < 2; ++ai)
#pragma unroll
            for (int m = 0; m < 4; ++m) { bf16_t* rowp = base + (size_t)(row0 + ai * HALF + m * 16) * ldc + col0;
#pragma unroll
                for (int bj = 0; bj < 2; ++bj) { f32x4 v0 = acc[ai][bj][m][0] + bv[bj][0], v1 = acc[ai][bj][m][1] + bv[bj][1];
                    if (ACT == 1) { f32x2 a = gelu_pk((f32x2){v0[0], v0[1]}), b = gelu_pk((f32x2){v0[2], v0[3]}), c = gelu_pk((f32x2){v1[0], v1[1]}), d = gelu_pk((f32x2){v1[2], v1[3]});
                        v0 = (f32x4){a.x, a.y, b.x, b.y}; v1 = (f32x4){c.x, c.y, d.x, d.y}; }
                    v0 = v0 * sc; v1 = v1 * sc; u32x4 w; w.x = cvt_pk_bf16(v0[0], v0[1]); w.y = cvt_pk_bf16(v0[2], v0[3]); w.z = cvt_pk_bf16(v1[0], v1[1]); w.w = cvt_pk_bf16(v1[2], v1[3]);
                    *(u32x4*)(rowp + bj * HALF) = w; } }
    }
};
struct EpiSwiglu {
    static constexpr bool PERM = true, AFTER_DRAIN = false;
    bf16_t* O; int ldc;
    __device__ __forceinline__ void operator()(const f32x4 (&acc)[2][2][4][2], const Unit& u, int wr, int wc, int fr, int fq) const {
        const int row0 = u.pm * BM + wr * 64 + fr; const int col0 = u.pn * HALF + wc * 32 + 8 * fq;
#pragma unroll
        for (int ai = 0; ai < 2; ++ai)
#pragma unroll
            for (int m = 0; m < 4; ++m) { bf16_t* rowp = O + (size_t)(row0 + ai * HALF + m * 16) * ldc + col0;
                float a[8];
#pragma unroll
                for (int n = 0; n < 2; ++n)
#pragma unroll
                    for (int i = 0; i < 4; ++i) { const float g = acc[ai][0][m][n][i], uu = acc[ai][1][m][n][i];
                        const float sg = g * __builtin_amdgcn_rcpf(1.0f + __builtin_amdgcn_exp2f(-1.4426950408889634f * g)); a[n * 4 + i] = sg * uu; }
                u32x4 w; w.x = cvt_pk_bf16(a[0], a[1]); w.y = cvt_pk_bf16(a[2], a[3]); w.z = cvt_pk_bf16(a[4], a[5]); w.w = cvt_pk_bf16(a[6], a[7]);
                *(u32x4*)rowp = w; }
    }
};
struct EpiRes {
    static constexpr bool PERM = false, AFTER_DRAIN = false;
    const float* base0; const float* base1; float* out; const float* gate;
    __device__ __forceinline__ void operator()(const f32x4 (&acc)[2][2][4][2], const Unit& u, int wr, int wc, int fr, int fq) const {
        const int col0 = u.pn * BM + wc * 32 + 4 * fq; const int cond = u.pm < 32 ? 0 : 1 + ((u.pm - 32) >> 2);
        const float* base = u.pm < 32 ? base0 : base1;
        f32x4 gv[2][2];
#pragma unroll
        for (int bj = 0; bj < 2; ++bj)
#pragma unroll
            for (int n = 0; n < 2; ++n) gv[bj][n] = *(const f32x4*)(gate + cond * 1024 + col0 + bj * HALF + n * 16);
#pragma unroll
        for (int ai = 0; ai < 2; ++ai)
#pragma unroll
            for (int m = 0; m < 4; ++m) { const size_t off = (size_t)(u.pm * BM + ai * HALF + wr * 64 + m * 16 + fr) * 1024 + col0;
#pragma unroll
                for (int bj = 0; bj < 2; ++bj)
#pragma unroll
                    for (int n = 0; n < 2; ++n) { const f32x4 bs = *(const f32x4*)(base + off + bj * HALF + n * 16);
                        *(f32x4*)(out + off + bj * HALF + n * 16) = bs + gv[bj][n] * acc[ai][bj][m][n]; } }
    }
};
template <class Epi, class Sched, bool ALIGN_EPI = false, bool SP2 = false>
__device__ __forceinline__ void gemm_phase(PG8_LAS unsigned char* lds, const Gemm g, const Sched& S, const Epi& E, int tid_in) {
    const int tid = tid_in, wid = __builtin_amdgcn_readfirstlane(tid >> 6), lane = tid & 63, wr = wid >> 2, wc = wid & 3, fr = lane & 15, fq = lane >> 4;
    const int K = g.K, nt = K / BK;
    unsigned voffA[2], voffB[2];
#pragma unroll
    for (int i = 0; i < 2; ++i) { int R, C; stage_rc(tid * 16 + i * 8192, R, C); const int Rb = Epi::PERM ? ((R & ~31) + perm32(R & 31)) : R;
        voffA[i] = (unsigned)(R * K + C) * 2u; voffB[i] = (unsigned)(Rb * K + C) * 2u; }
    const size_t kstep = (size_t)(BK * 2);
    const size_t hstep = (size_t)HALF * K * 2;
    const size_t tstep = 2 * hstep;
    const unsigned ldsw = (unsigned)wid * 1024u;
    const int aoff = lds_byte(wr * 64 + fr, fq * 8), boff = lds_byte(wc * 32 + fr, fq * 8);
#define PG8_SA(b, h) (((b) * 2 + (h)) * HTB)
#define PG8_SB(b, h) ((4 + (b) * 2 + (h)) * HTB)
#define PG8_STAGE(bufoff, gbase, voff) do { _Pragma("unroll") for (int _i = 0; _i < 2; ++_i) \
        __builtin_amdgcn_global_load_lds((const unsigned*)((const char*)(gbase) + (voff)[_i]), (PG8_LAS unsigned*)(lds + (bufoff) + ldsw + _i * 8192), 16, 0, 0); } while (0)
#define PG8_LDA(dst, b, h) do { _Pragma("unroll") for (int m = 0; m < 4; ++m) _Pragma("unroll") for (int k = 0; k < 2; ++k) dst[m][k] = *(const PG8_LAS bf16x8*)(lds + PG8_SA(b, h) + aoff + m * 2048 + k * 1024); } while (0)
#define PG8_LDB(dst, b, h) do { _Pragma("unroll") for (int n = 0; n < 2; ++n) _Pragma("unroll") for (int k = 0; k < 2; ++k) dst[n][k] = *(const PG8_LAS bf16x8*)(lds + PG8_SB(b, h) + boff + n * 2048 + k * 1024); } while (0)
#define PG8_MMA(ai, bj, At, Bt) do { __builtin_amdgcn_s_setprio(1); _Pragma("unroll") for (int m = 0; m < 4; ++m) _Pragma("unroll") for (int n = 0; n < 2; ++n) _Pragma("unroll") for (int k = 0; k < 2; ++k) \
        acc[ai][bj][m][n] = __builtin_amdgcn_mfma_f32_16x16x32_bf16(Bt[n][k], At[m][k], acc[ai][bj][m][n], 0, 0, 0); __builtin_amdgcn_s_setprio(0); } while (0)
#define PG8_WAIT_V(n) asm volatile("s_waitcnt vmcnt(" #n ")" ::: "memory")
#define PG8_WAIT_L(n) asm volatile("s_waitcnt lgkmcnt(" #n ")" ::: "memory")
#define PG8_BAR __builtin_amdgcn_s_barrier()
#define PG8_SCHED __builtin_amdgcn_sched_barrier(0)
    Unit cur, nxt; int ui = 0;
    if (!S.next(0, cur)) return;
    f32x4 acc[2][2][4][2];
#pragma unroll
    for (int a = 0; a < 2; ++a)
#pragma unroll
        for (int b = 0; b < 2; ++b)
#pragma unroll
            for (int m = 0; m < 4; ++m)
#pragma unroll
                for (int n = 0; n < 2; ++n) acc[a][b][m][n] = (f32x4){0.f, 0.f, 0.f, 0.f};
    bf16x8 At[4][2], B0[2][2], B1[2][2];
    const char* cA = (const char*)g.A + (size_t)cur.pm * tstep; const char* cB = (const char*)g.Bt + (size_t)cur.pn * tstep;
    S.a_ready(cur);
    if constexpr (SP2) {
        PG8_STAGE(PG8_SB(0, 0), cB, voffB); PG8_STAGE(PG8_SB(0, 1), cB + hstep, voffB); PG8_STAGE(PG8_SA(0, 0), cA, voffA); PG8_STAGE(PG8_SA(0, 1), cA + hstep, voffA);
        if (wr == 1) PG8_BAR;
        PG8_WAIT_V(2); PG8_BAR;
        PG8_STAGE(PG8_SB(1, 0), cB + kstep, voffB); PG8_STAGE(PG8_SA(1, 0), cA + kstep, voffA); PG8_STAGE(PG8_SB(1, 1), cB + hstep + kstep, voffB);
        PG8_WAIT_V(6); PG8_BAR;
    } else {
        PG8_STAGE(PG8_SB(0, 0), cB, voffB); PG8_STAGE(PG8_SA(0, 0), cA, voffA); PG8_STAGE(PG8_SB(0, 1), cB + hstep, voffB); PG8_STAGE(PG8_SA(0, 1), cA + hstep, voffA);
        if (wr == 1) PG8_BAR;
        PG8_WAIT_V(4); PG8_BAR;
        PG8_STAGE(PG8_SB(1, 0), cB + kstep, voffB); PG8_STAGE(PG8_SA(1, 0), cA + kstep, voffA); PG8_STAGE(PG8_SB(1, 1), cB + hstep + kstep, voffB);
        PG8_WAIT_V(6); PG8_BAR;
    }
    for (;;) {
        const bool has_next = S.next(ui + 1, nxt);
        const char* nA = has_next ? (const char*)g.A + (size_t)nxt.pm * tstep : cA; const char* nB = has_next ? (const char*)g.Bt + (size_t)nxt.pn * tstep : cB;
        for (int t = 0; t < nt; t += 2) {
            const bool last = (t == nt - 2);
            const char* a1 = cA + (size_t)(t + 1) * kstep;
            const char* a2 = last ? nA : cA + (size_t)(t + 2) * kstep; const char* b2 = last ? nB : cB + (size_t)(t + 2) * kstep;
            const char* a3 = a2 + kstep; const char* b3 = b2 + kstep;
            if (last && has_next) S.a_ready(nxt);
            if constexpr (SP2) {
            PG8_LDB(B0, 0, 0); PG8_LDB(B1, 0, 1); PG8_SCHED; PG8_LDA(At, 0, 0); PG8_STAGE(PG8_SA(1, 1), a1 + hstep, voffA);
            PG8_WAIT_V(8); PG8_WAIT_L(0); PG8_BAR; PG8_MMA(0, 0, At, B0); PG8_MMA(0, 1, At, B1); PG8_BAR; PG8_SCHED;
            PG8_LDA(At, 0, 1); PG8_STAGE(PG8_SB(0, 0), b2, voffB); PG8_STAGE(PG8_SB(0, 1), b2 + hstep, voffB); PG8_STAGE(PG8_SA(0, 0), a2, voffA);
            PG8_WAIT_V(8); PG8_WAIT_L(0); PG8_BAR; PG8_MMA(1, 0, At, B0); PG8_MMA(1, 1, At, B1); PG8_BAR; PG8_SCHED;
            PG8_LDB(B0, 1, 0); PG8_LDB(B1, 1, 1); PG8_SCHED; PG8_LDA(At, 1, 0); PG8_STAGE(PG8_SA(0, 1), a2 + hstep, voffA);
            PG8_WAIT_V(8); PG8_WAIT_L(0); PG8_BAR; PG8_MMA(0, 0, At, B0); PG8_MMA(0, 1, At, B1); PG8_BAR; PG8_SCHED;
            PG8_LDA(At, 1, 1); PG8_STAGE(PG8_SB(1, 0), b3, voffB); PG8_STAGE(PG8_SB(1, 1), b3 + hstep, voffB); PG8_STAGE(PG8_SA(1, 0), a3, voffA);
            PG8_WAIT_V(8); PG8_WAIT_L(0); PG8_BAR; PG8_MMA(1, 0, At, B0); PG8_MMA(1, 1, At, B1); PG8_BAR; PG8_SCHED;
            } else {
            PG8_LDB(B0, 0, 0); PG8_SCHED; PG8_LDA(At, 0, 0); PG8_STAGE(PG8_SA(1, 1), a1 + hstep, voffA);
            PG8_WAIT_L(8); PG8_BAR; PG8_WAIT_L(0); PG8_MMA(0, 0, At, B0); PG8_BAR; PG8_SCHED;
            PG8_LDB(B1, 0, 1); PG8_STAGE(PG8_SB(0, 0), b2, voffB);
            PG8_BAR; PG8_WAIT_L(0); PG8_MMA(0, 1, At, B1); PG8_BAR;
            PG8_LDA(At, 0, 1); PG8_STAGE(PG8_SA(0, 0), a2, voffA);
            PG8_BAR; PG8_WAIT_L(0); PG8_MMA(1, 0, At, B0); PG8_BAR; PG8_SCHED;
            PG8_STAGE(PG8_SB(0, 1), b2 + hstep, voffB);
            PG8_WAIT_V(6); PG8_BAR; PG8_MMA(1, 1, At, B1); PG8_BAR;
            PG8_LDB(B0, 1, 0); PG8_SCHED; PG8_LDA(At, 1, 0); PG8_STAGE(PG8_SA(0, 1), a2 + hstep, voffA);
            PG8_WAIT_L(8); PG8_BAR; PG8_WAIT_L(0); PG8_MMA(0, 0, At, B0); PG8_BAR; PG8_SCHED;
            PG8_LDB(B1, 1, 1); PG8_STAGE(PG8_SB(1, 0), b3, voffB);
            PG8_BAR; PG8_WAIT_L(0); PG8_MMA(0, 1, At, B1); PG8_BAR;
            PG8_LDA(At, 1, 1); PG8_STAGE(PG8_SA(1, 0), a3, voffA);
            PG8_BAR; PG8_WAIT_L(0); PG8_MMA(1, 0, At, B0); PG8_BAR; PG8_SCHED;
            PG8_STAGE(PG8_SB(1, 1), b3 + hstep, voffB);
            PG8_WAIT_V(6); PG8_BAR; PG8_MMA(1, 1, At, B1); PG8_BAR;
            }
        }
        if constexpr (ALIGN_EPI) { if (wr == 0) PG8_BAR; }
        if constexpr (!Epi::AFTER_DRAIN) { E(acc, cur, wr, wc, fr, fq); S.done(cur); }
        if (!has_next) break;
#pragma unroll
        for (int a = 0; a < 2; ++a)
#pragma unroll
            for (int b = 0; b < 2; ++b)
#pragma unroll
                for (int m = 0; m < 4; ++m)
#pragma unroll
                    for (int n = 0; n < 2; ++n) acc[a][b][m][n] = (f32x4){0.f, 0.f, 0.f, 0.f};
        cur = nxt; cA = nA; cB = nB; ++ui;
        if constexpr (ALIGN_EPI) { if (wr == 1) PG8_BAR; }
    }
    PG8_WAIT_V(0);
    if constexpr (!ALIGN_EPI) { if (wr == 0) PG8_BAR; }
    PG8_BAR;
    if constexpr (Epi::AFTER_DRAIN) { E.fused(acc, cur, wr, wc, fr, fq, lds, wid, lane); S.done(cur); }
#undef PG8_SA
#undef PG8_SB
#undef PG8_STAGE
#undef PG8_LDA
#undef PG8_LDB
#undef PG8_MMA
#undef PG8_WAIT_V
#undef PG8_WAIT_L
#undef PG8_BAR
#undef PG8_SCHED
}
}
#define GAS __attribute__((address_space(1)))
#define LAS __attribute__((address_space(3)))
typedef unsigned short bf16;
typedef unsigned v4u __attribute__((ext_vector_type(4)));
typedef float f32x4 __attribute__((ext_vector_type(4)));
typedef short bf16x8 __attribute__((ext_vector_type(8)));
typedef GAS unsigned gu32;
typedef GAS unsigned long long gu64;
#define RLX_AGENT __ATOMIC_RELAXED, __HIP_MEMORY_SCOPE_AGENT
#define LDS_WAIT() asm volatile("s_waitcnt lgkmcnt(0)" ::: "memory")
#define VM_WAIT() asm volatile("s_waitcnt vmcnt(0)" ::: "memory")
__device__ __forceinline__ unsigned long long rt() { return __builtin_amdgcn_s_memrealtime(); }
__device__ __forceinline__ unsigned f2bf(float f) { unsigned u = __builtin_bit_cast(unsigned, f); return (u + 0x7fffu + ((u >> 16) & 1u)) >> 16; }
__device__ __forceinline__ unsigned pk2(float lo, float hi) { return f2bf(lo) | (f2bf(hi) << 16); }

#define XB_TMO      128
#define XB_XCNT(j)  (256  + 64 * (j))
#define XB_XSUB(j)  (1280 + 64 * (j))
#define XB_XGEN(j)  (2304 + 64 * (j))
#define XB_TOP      3328
#define XB_TOPGEN   3392
#define XCD_BAR_WORDS 3456
#define XB_SPIN_CAP (1u << 18)

__device__ __forceinline__ unsigned xb_ld(unsigned* p)              { return __hip_atomic_load(p, __ATOMIC_RELAXED, __HIP_MEMORY_SCOPE_AGENT); }
__device__ __forceinline__ unsigned xb_add(unsigned* p, unsigned v) { return __hip_atomic_fetch_add(p, v, __ATOMIC_RELAXED, __HIP_MEMORY_SCOPE_AGENT); }
__device__ __forceinline__ unsigned xb_xcc_id() { return (unsigned)__builtin_amdgcn_s_getreg((3 << 11) | 20) & 0xFu; }
#define XB_SPIN(cond, bar) do { unsigned _sp = 0; while (cond) { __builtin_amdgcn_s_sleep(1); \
    if ((++_sp & 255u) == 0u) { if (xb_ld(&(bar)[XB_TMO])) break; if (_sp > XB_SPIN_CAP) { atomicAdd(&(bar)[XB_TMO], 1u); break; } } } } while (0)

struct XcdBarrier {
    unsigned* bar; unsigned x;
    volatile LAS unsigned* st;
};

__device__ __forceinline__ XcdBarrier xcd_barrier_post(unsigned* bar, volatile LAS unsigned* st) {
    XcdBarrier b; b.bar = bar; b.x = xb_xcc_id(); b.st = st;
    if (threadIdx.x == 0) (void)xb_add(&bar[XB_XCNT(b.x)], 1u);
    return b;
}
__device__ __forceinline__ void xcd_barrier_complete(unsigned* bar, unsigned x, unsigned& nloc, unsigned& nx) {
    const unsigned G = gridDim.x * gridDim.y * gridDim.z;
    unsigned sum, cnt, mine, sp = 0u;
    for (;;) {
        sum = 0u; cnt = 0u; mine = 0u;
#pragma unroll
        for (unsigned j = 0; j < 16; ++j) { const unsigned c = xb_ld(&bar[XB_XCNT(j)]); sum += c; cnt += (c > 0u) ? 1u : 0u; mine = (j == x) ? c : mine; }
        if (sum == G) break;
        __builtin_amdgcn_s_sleep(1);
        if ((++sp & 255u) == 0u) { if (xb_ld(&bar[XB_TMO])) break; if (sp > XB_SPIN_CAP) { atomicAdd(&bar[XB_TMO], 1u); break; } }
    }
    nloc = mine > 0u ? mine : 1u; nx = cnt > 0u ? cnt : 1u;
}

__device__ __forceinline__ void xcd_barrier(const XcdBarrier& b) {
    asm volatile("s_waitcnt vmcnt(0)" ::: "memory");
    __syncthreads();
    if (threadIdx.x == 0) {
        unsigned* bar = b.bar;
        __builtin_amdgcn_s_waitcnt(0);
        unsigned nloc = b.st[0], nx = b.st[1];
        if (nloc == 0u) { xcd_barrier_complete(bar, b.x, nloc, nx); b.st[0] = nloc; b.st[1] = nx; }
        const unsigned old = xb_add(&bar[XB_XSUB(b.x)], 1u);
        const unsigned gen = old / nloc;
        if (old + 1u == (gen + 1u) * nloc) {
            __builtin_amdgcn_fence(__ATOMIC_RELEASE, "agent");
            asm volatile("s_waitcnt vmcnt(0)" ::: "memory");
            const unsigned og = xb_add(&bar[XB_TOP], 1u);
            const unsigned tg = og / nx;
            if (og + 1u == (tg + 1u) * nx) xb_add(&bar[XB_TOPGEN], 1u);
            else XB_SPIN(xb_ld(&bar[XB_TOPGEN]) == tg, bar);
            __builtin_amdgcn_fence(__ATOMIC_ACQUIRE, "agent");
            xb_add(&bar[XB_XGEN(b.x)], 1u);
            asm volatile("s_waitcnt vmcnt(0)" ::: "memory");
        } else {
            XB_SPIN(xb_ld(&bar[XB_XGEN(b.x)]) == gen, bar);
            __builtin_amdgcn_fence(__ATOMIC_ACQUIRE, "agent");
            asm volatile("s_waitcnt vmcnt(0)" ::: "memory");
        }
    }
    __syncthreads();
}

constexpr int NWAVES = 8;
constexpr int D = 1024, M = 12288, MC = 8192, FF = 2816, NGU = 5632, ZW = 2560;
constexpr int ZC_Y = 0, ZC_HQ = 512, ZC_HI = 768, ZC_HFF = 1024, ZC_HFB = 1280, ZC_HG = 1536, ZC_AQ = 1792, ZC_AK = 2304, ZC_AV = 2432;
constexpr int NCHUNK = M / 32;
constexpr float QSCALE = 0.125f * 1.4426950408889634f;
constexpr float LOG2E = 1.4426950408889634f;
constexpr size_t MiB = 1u << 20;
constexpr size_t WS_CTL = 0, CTL_ZERO_BYTES = 1 * MiB;
constexpr size_t WS_MODP = 1 * MiB;
constexpr size_t WS_MODT = 7 * MiB;
constexpr size_t WS_T1024 = 8 * MiB, WS_T256 = 12 * MiB;
constexpr size_t WS_KC = 13 * MiB, WS_VCT = 14 * MiB;
constexpr size_t WS_WGU = 16 * MiB, WGU_SZ = 11 * MiB;
constexpr size_t WS_WDN = 60 * MiB, WDN_SZ = 11 * MiB / 2;
constexpr size_t WS_WIN = 82 * MiB, WIN_SZ = 5 * MiB;
constexpr size_t WS_WOUT = 92 * MiB, WOUT_SZ = 2 * MiB;
constexpr size_t WS_H = 96 * MiB;
constexpr size_t WS_QR = 96 * MiB, WS_KR = 108 * MiB;
constexpr size_t WS_ACT = 120 * MiB;
constexpr size_t WS_Z = 120 * MiB, WS_EB = 180 * MiB, WS_VTP = 181 * MiB;
constexpr size_t WS_MIX = 186 * MiB;
constexpr size_t WS_QINP = 210 * MiB, WS_KOUTT = 222 * MiB, WS_VT = 234 * MiB, WS_YT = 246 * MiB, WS_OSC = 258 * MiB, WS_END = 270 * MiB;
constexpr int CW_BAR = 4096;
constexpr int CW_Q = 16384;
constexpr int RING_BYTES = 131072, LDSCTL_OFF = RING_BYTES, MISC_OFF = LDSCTL_OFF + 320, LDS_BYTES = 147456;
constexpr int OUT_YP = 0, OUT_YS = 8388608, OUT_CK = 12582912, OUT_CV = 14680064, OUT_ST = 16777216, OUT_TOTAL = 18874368;

typedef float f32x16 __attribute__((ext_vector_type(16)));
typedef unsigned u32x2 __attribute__((ext_vector_type(2)));
__device__ __forceinline__ float bf2f(unsigned b) { return __uint_as_float(b << 16); }
__device__ __forceinline__ float ex2(float x) { return __builtin_amdgcn_exp2f(x); }
__device__ __forceinline__ float expf_fast(float x) { return __builtin_amdgcn_exp2f(x * LOG2E); }
__device__ __forceinline__ int swap23(int s) { return (s & ~12) | ((s & 4) << 1) | ((s & 8) >> 1); }
__device__ __forceinline__ bf16x8 pack8(const float* a) { v4u w; w.x = pk2(a[0], a[1]); w.y = pk2(a[2], a[3]); w.z = pk2(a[4], a[5]); w.w = pk2(a[6], a[7]); return __builtin_bit_cast(bf16x8, w); }
__device__ __forceinline__ int krow(int reg, int h) { return (reg & 3) + 8 * (reg >> 2) + 4 * h; }

typedef const float* fptr_t;
#define KIN(i) (((const fptr_t __attribute__((address_space(4)))*)__builtin_amdgcn_kernarg_segment_ptr())[i])
struct Frame {
    LAS unsigned char* lds; volatile LAS unsigned* MISC; gu32* ctl;
    int tid, lane, wave, G;
    float* out; unsigned char* ws;
};

__device__ __forceinline__ void p0_transpose_item(const float* W, int ldw, bf16* WT, int K, int dst_row0, int src_col0, int k0, LAS float* scr, int lane) {
    float v[32];
#pragma unroll
    for (int i = 0; i < 32; ++i) { const int kk = 2 * i + (lane >> 5); v[i] = W[(size_t)(k0 + kk) * ldw + src_col0 + (lane & 31)]; }
#pragma unroll
    for (int i = 0; i < 32; ++i) { const int kk = 2 * i + (lane >> 5); scr[kk * 33 + (lane & 31)] = v[i]; }
    LDS_WAIT(); asm volatile("" ::: "memory");
    const int c = lane & 7;
#pragma unroll
    for (int j = 0; j < 4; ++j) { const int n = (lane >> 3) + 8 * j; const LAS float* s = scr + (8 * c) * 33 + n;
        v4u o; o.x = pk2(s[0 * 33], s[1 * 33]); o.y = pk2(s[2 * 33], s[3 * 33]); o.z = pk2(s[4 * 33], s[5 * 33]); o.w = pk2(s[6 * 33], s[7 * 33]);
        *(GAS v4u*)(WT + (size_t)(dst_row0 + n) * K + k0 + 8 * c) = o; }
    LDS_WAIT(); asm volatile("" ::: "memory");
}
__device__ __forceinline__ void p0_fold_item(const float* Win, bf16* WT, int n0, int k0, LAS float* scr, int lane) {
    const int comp = n0 >> 8, g = (n0 & 255) >> 6, c0 = n0 & 63;
    LAS float* tw = scr + 32 * 65; LAS float* scr2 = tw + 64;
    tw[lane] = __builtin_amdgcn_cosf((float)lane * (1.0f / 64.0f)) * 0.125f;
#pragma unroll 8
    for (int i = 0; i < 32; ++i) scr[i * 65 + lane] = Win[(size_t)(k0 + i) * 2304 + g * 64 + lane];
    LDS_WAIT(); asm volatile("" ::: "memory");
    const int kk = lane & 31, ch = lane >> 5;
    for (int ci = 0; ci < 16; ++ci) { const int cl = ch * 16 + ci, c = c0 + cl; float a = 0.f;
#pragma unroll 8
        for (int d = 0; d < 64; ++d) { const int idx = (c * d) & 63; const float t = comp ? -tw[(idx - 16) & 63] : tw[idx]; a += scr[kk * 65 + d] * t; }
        scr2[cl * 33 + kk] = a; }
    LDS_WAIT(); asm volatile("" ::: "memory");
#pragma unroll
    for (int j = 0; j < 2; ++j) { const int q = lane + 64 * j, c = q >> 2, kc = q & 3; const LAS float* s = scr2 + c * 33 + 8 * kc;
        v4u o; o.x = pk2(s[0], s[1]); o.y = pk2(s[2], s[3]); o.z = pk2(s[4], s[5]); o.w = pk2(s[6], s[7]);
        *(GAS v4u*)(WT + (size_t)(n0 + c) * 1024 + k0 + 8 * kc) = o; }
    LDS_WAIT(); asm volatile("" ::: "memory");
}
__device__ __forceinline__ void p0_mod_item(Frame& F, int it, int lane) {
    const int l = it / 576, rem = it % 576, cb = rem >> 4, ks = rem & 15;
    const int k = ks * 64 + lane;
    float sv[5];
    { const float x = KIN(6)[k]; sv[0] = x * __builtin_amdgcn_rcpf(1.0f + expf_fast(-x)); }
#pragma unroll
    for (int c = 1; c < 5; ++c) { const float x = KIN(2)[(c - 1) * 1024 + k]; sv[c] = x * __builtin_amdgcn_rcpf(1.0f + expf_fast(-x)); }
    f32x4 acc[5];
#pragma unroll
    for (int c = 0; c < 5; ++c) acc[c] = (f32x4){0.f, 0.f, 0.f, 0.f};
    const float* wp = KIN(7) + ((size_t)l * 1024 + ks * 64) * 9216 + cb * 256 + lane * 4;
#pragma unroll 8
    for (int kk = 0; kk < 64; ++kk) { const f32x4 w = *(const f32x4*)(wp + (size_t)kk * 9216);
#pragma unroll
        for (int c = 0; c < 5; ++c) { const float s = __shfl(sv[c], kk); acc[c] += w * s; } }
    float* mp = (float*)(F.ws + WS_MODP);
#pragma unroll
    for (int c = 0; c < 5; ++c) *(f32x4*)(mp + ((size_t)((ks * 2 + l) * 5 + c)) * 9216 + cb * 256 + lane * 4) = acc[c];
}
__device__ __forceinline__ void p0_twiddle_row(bf16* T, int L, int p, int lane) {
    const float sc = L == 1024 ? 0.03125f : 0.0625f, invL = 1.0f / (float)L;
    for (int j = 0; j < (2 * L) / 512; ++j) { const int col0 = (j * 64 + lane) * 8; float a[8];
#pragma unroll
        for (int i = 0; i < 8; ++i) { const int col = col0 + i, comp = col >= L, t = col - comp * L; const float x = (float)((p * t) & (L - 1)) * invL;
            a[i] = (comp ? __builtin_amdgcn_sinf(x) : __builtin_amdgcn_cosf(x)) * sc; }
        *(GAS bf16x8*)(T + (size_t)p * 2 * L + col0) = pack8(a); }
}
__device__ __forceinline__ void p0_cache_item(Frame& F, int it, int lane) {
    const int blk = it & 15, kvh = (it >> 4) & 1, bl = it >> 5;
    bf16* KC = (bf16*)(F.ws + WS_KC); bf16* VCT = (bf16*)(F.ws + WS_VCT);
    float vv[32];
#pragma unroll
    for (int i = 0; i < 32; ++i) { const size_t src = (((size_t)bl * 512 + blk * 32 + i) * 2 + kvh) * 64 + lane;
        KC[(((size_t)bl * 2 + kvh) * 512 + blk * 32 + i) * 64 + lane] = (bf16)f2bf(KIN(3)[src]); vv[i] = KIN(4)[src]; }
    float a[32];
#pragma unroll
    for (int s = 0; s < 32; ++s) a[s] = vv[swap23(s)];
    bf16* dst = VCT + (((size_t)bl * 2 + kvh) * 64 + lane) * 512 + blk * 32;
#pragma unroll
    for (int j = 0; j < 4; ++j) *(GAS bf16x8*)(dst + 8 * j) = pack8(a + 8 * j);
}
__device__ __forceinline__ void p0_prologue(Frame& F) {
    LAS float* scr = (LAS float*)(F.lds + F.wave * 16384);
    const int gw = blockIdx.x * NWAVES + F.wave, NGW = F.G * NWAVES;
    constexpr int I_GU = 16 * 176, I_DN = 44 * 32, I_WIN = 16 * 64, I_FOLD = 32 * 16, I_WOUT = 16 * 32, I_LAYER = 2 * I_GU + 2 * I_DN + I_WIN + I_FOLD + I_WOUT;
    constexpr int I_W = 2 * I_LAYER, I_MOD = 2 * 576, I_TW = 1024 + 256, I_CACHE = 256, NITEMS = I_MOD + I_W + I_TW + I_CACHE;
    for (int it = gw; it < NITEMS; it += NGW) {
        int r = it;
        if (r < I_MOD) { p0_mod_item(F, r, F.lane); continue; } r -= I_MOD;
        if (r < I_W) { const int l = r / I_LAYER; r -= l * I_LAYER;
            if (r < 2 * I_GU) { const int f = r / I_GU; r -= f * I_GU; const int kb = r / 176, nb = r % 176, n0 = 32 * nb;
                const int src = ((n0 >> 7) & 1) * FF + 128 * (n0 >> 8) + (n0 & 127);
                p0_transpose_item(KIN(f ? 14 : 12) + (size_t)l * D * NGU, NGU, (bf16*)(F.ws + WS_WGU + (size_t)(l * 2 + f) * WGU_SZ), D, n0, src, 64 * kb, scr, F.lane); continue; }
            r -= 2 * I_GU;
            if (r < 2 * I_DN) { const int f = r / I_DN; r -= f * I_DN; const int kb = r / 32, nb = r % 32;
                p0_transpose_item(KIN(f ? 15 : 13) + (size_t)l * FF * D, D, (bf16*)(F.ws + WS_WDN + (size_t)(l * 2 + f) * WDN_SZ), FF, 32 * nb, 32 * nb, 64 * kb, scr, F.lane); continue; }
            r -= 2 * I_DN;
            if (r < I_WIN) { const int kb = r / 64, nb = r % 64;
                p0_transpose_item(KIN(16) + (size_t)l * D * 2304, 2304, (bf16*)(F.ws + WS_WIN + (size_t)l * WIN_SZ), D, 512 + 32 * nb, 256 + 32 * nb, 64 * kb, scr, F.lane); continue; }
            r -= I_WIN;
            if (r < I_FOLD) { const int kb = r / 16, nb = r % 16;
                p0_fold_item(KIN(16) + (size_t)l * D * 2304, (bf16*)(F.ws + WS_WIN + (size_t)l * WIN_SZ), 32 * nb, 32 * kb, scr, F.lane); continue; }
            r -= I_FOLD;
            { const int kb = r / 32, nb = r % 32;
                p0_transpose_item(KIN(17) + (size_t)l * D * D, D, (bf16*)(F.ws + WS_WOUT + (size_t)l * WOUT_SZ), D, 32 * nb, 32 * nb, 64 * kb, scr, F.lane); continue; }
        }
        r -= I_W;
        if (r < I_TW) { if (r < 1024) p0_twiddle_row((bf16*)(F.ws + WS_T1024), 1024, r, F.lane); else p0_twiddle_row((bf16*)(F.ws + WS_T256), 256, r - 1024, F.lane); continue; }
        r -= I_TW;
        p0_cache_item(F, r, F.lane);
    }
}
__device__ __forceinline__ void p0b_modtables(Frame& F) {
    const float* mp = (const float*)(F.ws + WS_MODP); float* mt = (float*)(F.ws + WS_MODT);
    for (int idx = blockIdx.x * 512 + F.tid; idx < 2 * 3 * 5 * 1024; idx += F.G * 512) {
        const int col = idx & 1023, c = (idx >> 10) % 5, lk = idx / 5120, k = lk % 3, l = lk / 3;
        float m[3];
#pragma unroll
        for (int j = 0; j < 3; ++j) { const int comp = 3 * k + j; float s = KIN(8)[l * 9216 + comp * 1024 + col];
#pragma unroll
            for (int ks = 0; ks < 16; ++ks) s += mp[((size_t)((ks * 2 + l) * 5 + c)) * 9216 + comp * 1024 + col];
            m[j] = s; }
        const float nw = KIN(9 + k)[l * 1024 + col];
        mt[idx] = nw * (1.0f + m[1]); mt[30720 + idx] = m[0]; mt[61440 + idx] = m[2] * (k == 1 ? 1.0f : 0.5f);
    }
}
__device__ __forceinline__ const float* mod_tab(Frame& F, int which, int l, int k) { return (const float*)(F.ws + WS_MODT) + which * 30720 + (l * 3 + k) * 5120; }

__device__ __forceinline__ void norm_phase(Frame& F, const float* x0, const float* x1, const float* At, const float* St) {
    bf16* H = (bf16*)(F.ws + WS_H);
    const int gw = blockIdx.x * NWAVES + F.wave, NGW = F.G * NWAVES;
    for (int m = gw; m < M; m += NGW) {
        const float* xr = (m < MC ? x0 : x1) + (size_t)m * D; const int cond = m < MC ? 0 : 1 + ((m - MC) >> 10);
        f32x4 v[4]; float s = 0.f;
#pragma unroll
        for (int j = 0; j < 4; ++j) { v[j] = *(const f32x4*)(xr + 4 * F.lane + 256 * j); s += (v[j].x * v[j].x + v[j].y * v[j].y) + (v[j].z * v[j].z + v[j].w * v[j].w); }
#pragma unroll
        for (int o = 1; o < 64; o <<= 1) s += __shfl_xor(s, o);
        const float r = 1.0f / sqrtf(s * (1.0f / D) + 1e-6f);
#pragma unroll
        for (int j = 0; j < 4; ++j) { const f32x4 a = *(const f32x4*)(At + cond * 1024 + 4 * F.lane + 256 * j), sh = *(const f32x4*)(St + cond * 1024 + 4 * F.lane + 256 * j);
            const f32x4 h = v[j] * r * a + sh; u32x2 w; w.x = pk2(h.x, h.y); w.y = pk2(h.z, h.w);
            *(u32x2*)(H + (size_t)m * D + 4 * F.lane + 256 * j) = w; }
    }
}

struct ChunkInfo { int L, rowbase, cs, cg0, seq; bool lat; };
__device__ __forceinline__ ChunkInfo chunk_info(int chunk) {
    ChunkInfo c;
    if (chunk < 256) { c.lat = false; c.seq = chunk >> 3; c.cs = chunk & 7; c.L = 256; c.rowbase = c.seq * 256; c.cg0 = c.seq * 8; }
    else { const int cc = chunk - 256; c.lat = true; c.seq = cc >> 5; c.cs = cc & 31; c.L = 1024; c.rowbase = MC + c.seq * 1024; c.cg0 = 256 + c.seq * 32; }
    return c;
}
__device__ __forceinline__ void prep_hgrn(Frame& F, int l, const ChunkInfo& ci) {
    const bf16* Z = (const bf16*)(F.ws + WS_Z);
    const int dr = F.tid >> 8, ch = F.tid & 255;
    float lb = 0.f;
    if (l == 1) { const float a0 = KIN(18)[(0 * 2 + dr) * 256 + ch], a1 = KIN(18)[(1 * 2 + dr) * 256 + ch]; lb = 1.0f / (1.0f + expf_fast(a0 - a1)); }
    const float lbf = fmaxf(lb, 1e-30f), oml = 1.0f - lb;
    float bb[32], kv[32];
    float b = 0.f;
#pragma unroll
    for (int i = 0; i < 32; ++i) { const int tau = 32 * ci.cs + i, t = dr ? ci.L - 1 - tau : tau; const bf16* zr = Z + (size_t)(ci.rowbase + t) * ZW;
        const float zf = fmaxf(bf2f(zr[(dr ? ZC_HFB : ZC_HFF) + ch]), -60.0f);
        const float e = expf_fast(-zf), sig = __builtin_amdgcn_rcpf(1.0f + e), sneg = e * sig;
        const float f = lbf + oml * sig; b += __builtin_amdgcn_logf(f) * 0.6931471805599453f;
        bb[i] = b; kv[i] = oml * sneg; }
    const float bref = bb[15], bT = bb[31];
    bf16* QR = (bf16*)(F.ws + WS_QR); bf16* KR = (bf16*)(F.ws + WS_KR); bf16* QINP = (bf16*)(F.ws + WS_QINP);
    const int chp = (ch & ~63) | swap23(ch & 63);
#pragma unroll
    for (int i = 0; i < 32; ++i) { const int tau = 32 * ci.cs + i, t = dr ? ci.L - 1 - tau : tau;
        const float qv = bf2f(Z[(size_t)(ci.rowbase + t) * ZW + ZC_HQ + ch]) * 0.125f;
        const size_t p = ((size_t)(ci.rowbase + tau) * 2 + dr) * 256;
        QR[p + ch] = (bf16)f2bf(qv * expf_fast(fminf(bb[i] - bref, 80.f)));
        KR[p + ch] = (bf16)f2bf(kv[i] * expf_fast(fminf(bref - bb[i], 80.f)));
        QINP[p + chp] = (bf16)f2bf(qv * expf_fast(bb[i])); }
    const int cg = ci.cg0 + ci.cs;
    const size_t tb = (((size_t)cg * 2 + dr) * 256 + ch) * 32;
    bf16* KOUTT = (bf16*)(F.ws + WS_KOUTT) + tb; bf16* VT = (bf16*)(F.ws + WS_VT) + tb;
#pragma unroll
    for (int j = 0; j < 4; ++j) { float a[8];
#pragma unroll
        for (int e = 0; e < 8; ++e) { const int i = swap23(8 * j + e); a[e] = kv[i] * expf_fast(bT - bb[i]); }
        *(GAS bf16x8*)(KOUTT + 8 * j) = pack8(a); }
#pragma unroll
    for (int j = 0; j < 4; ++j) { unsigned vv[8];
#pragma unroll
        for (int e = 0; e < 8; ++e) { const int tau = 32 * ci.cs + swap23(8 * j + e), t = dr ? ci.L - 1 - tau : tau; vv[e] = Z[(size_t)(ci.rowbase + t) * ZW + ZC_HI + ch]; }
        v4u w; w.x = vv[0] | (vv[1] << 16); w.y = vv[2] | (vv[3] << 16); w.z = vv[4] | (vv[5] << 16); w.w = vv[6] | (vv[7] << 16);
        *(GAS v4u*)(VT + 8 * j) = w; }
    ((float*)(F.ws + WS_EB))[((size_t)cg * 2 + dr) * 256 + ch] = expf_fast(bT);
}
__device__ __forceinline__ void head_norm_rope(float (&x)[32], const float* nw, bool rope, int pos, float scale) {
    float ss = 0.f;
#pragma unroll
    for (int j = 0; j < 32; ++j) ss += x[j] * x[j];
    ss += __shfl_xor(ss, 1);
    const float r = 1.0f / sqrtf(ss * (1.0f / 64.0f) + 1e-6f);
#pragma unroll
    for (int j = 0; j < 32; ++j) x[j] = x[j] * r * nw[j];
    if (rope) {
#pragma unroll
        for (int j = 0; j < 16; ++j) { const float inv = ex2(-(float)j * (13.287712379549449f / 16.0f));
            const float rev = (float)pos * inv * 0.15915494309189535f; const float c = __builtin_amdgcn_cosf(rev), s = __builtin_amdgcn_sinf(rev);
            const float a = x[j], bq = x[j + 16]; x[j] = a * c - bq * s; x[j + 16] = bq * c + a * s; }
    }
#pragma unroll
    for (int j = 0; j < 32; ++j) x[j] *= scale;
}
__device__ __forceinline__ void load32(const bf16* p, float (&x)[32]) {
#pragma unroll
    for (int j = 0; j < 4; ++j) { const v4u w = *(const GAS v4u*)(p + 8 * j);
        x[8 * j + 0] = bf2f(w.x & 0xffffu); x[8 * j + 1] = bf2f(w.x >> 16); x[8 * j + 2] = bf2f(w.y & 0xffffu); x[8 * j + 3] = bf2f(w.y >> 16);
        x[8 * j + 4] = bf2f(w.z & 0xffffu); x[8 * j + 5] = bf2f(w.z >> 16); x[8 * j + 6] = bf2f(w.w & 0xffffu); x[8 * j + 7] = bf2f(w.w >> 16); }
}
__device__ __forceinline__ void store32(bf16* p, const float (&x)[32]) {
#pragma unroll
    for (int j = 0; j < 4; ++j) *(GAS bf16x8*)(p + 8 * j) = pack8(&x[8 * j]);
}
__device__ __forceinline__ void prep_misc(Frame& F, int l, const ChunkInfo& ci) {
    bf16* Z = (bf16*)(F.ws + WS_Z);
    const int row0 = ci.rowbase + 32 * ci.cs, cg = ci.cg0 + ci.cs;
    { const int col = F.tid; unsigned vv[32];
#pragma unroll
      for (int i = 0; i < 32; ++i) vv[i] = Z[(size_t)(row0 + i) * ZW + ZC_Y + col];
      bf16* YT = (bf16*)(F.ws + WS_YT) + (ci.lat ? (size_t)MC * 512 + (size_t)ci.seq * 512 * 1024 : (size_t)ci.seq * 512 * 256) + (size_t)col * ci.L + 32 * ci.cs;
#pragma unroll
      for (int j = 0; j < 4; ++j) { v4u w; w.x = vv[8 * j] | (vv[8 * j + 1] << 16); w.y = vv[8 * j + 2] | (vv[8 * j + 3] << 16); w.z = vv[8 * j + 4] | (vv[8 * j + 5] << 16); w.w = vv[8 * j + 6] | (vv[8 * j + 7] << 16);
          *(GAS v4u*)(YT + 8 * j) = w; } }
    { const int i = F.tid >> 4, hh = F.tid & 15, hq = hh >> 1, half = hh & 1, t = 32 * ci.cs + i;
      bf16* p = Z + (size_t)(row0 + i) * ZW + ZC_AQ + hq * 64 + half * 32; float x[32]; load32(p, x);
      head_norm_rope(x, KIN(20) + l * 64 + half * 32, ci.lat, half ? (t & 63) : (t >> 6), QSCALE); store32(p, x); }
    if (F.tid < 128) { const int i = F.tid >> 2, hh = F.tid & 3, kvh = hh >> 1, half = hh & 1, t = 32 * ci.cs + i;
      bf16* p = Z + (size_t)(row0 + i) * ZW + ZC_AK + kvh * 64 + half * 32; float x[32]; load32(p, x);
      head_norm_rope(x, KIN(21) + l * 64 + half * 32, ci.lat, half ? (t & 63) : (t >> 6), 1.0f); store32(p, x);
      if (!ci.lat) { float* o = F.out + OUT_CK + (((size_t)ci.seq * 2 + l) * 256 + t) * 128 + kvh * 64 + half * 32;
#pragma unroll
          for (int j = 0; j < 8; ++j) *(f32x4*)(o + 4 * j) = (f32x4){x[4 * j], x[4 * j + 1], x[4 * j + 2], x[4 * j + 3]}; } }
    else if (F.tid < 256) { const int vc = F.tid - 128; unsigned vv[32];
#pragma unroll
      for (int i = 0; i < 32; ++i) vv[i] = Z[(size_t)(row0 + i) * ZW + ZC_AV + vc];
      bf16* VTP = (bf16*)(F.ws + WS_VTP) + ((size_t)cg * 128 + vc) * 32;
#pragma unroll
      for (int j = 0; j < 4; ++j) { v4u w;
          w.x = vv[swap23(8 * j + 0)] | (vv[swap23(8 * j + 1)] << 16); w.y = vv[swap23(8 * j + 2)] | (vv[swap23(8 * j + 3)] << 16);
          w.z = vv[swap23(8 * j + 4)] | (vv[swap23(8 * j + 5)] << 16); w.w = vv[swap23(8 * j + 6)] | (vv[swap23(8 * j + 7)] << 16);
          *(GAS v4u*)(VTP + 8 * j) = w; }
      if (!ci.lat) {
#pragma unroll
          for (int i = 0; i < 32; ++i) F.out[OUT_CV + (((size_t)ci.seq * 2 + l) * 256 + 32 * ci.cs + i) * 128 + vc] = bf2f(vv[i]); } }
}
__device__ __forceinline__ void prep_phase(Frame& F, int l) {
    for (int it = blockIdx.x; it < 2 * NCHUNK; it += F.G) {
        const ChunkInfo ci = chunk_info(it >> 1);
        if (it & 1) prep_misc(F, l, ci); else prep_hgrn(F, l, ci);
    }
}

#define MFMA32(a, b, c) __builtin_amdgcn_mfma_f32_32x32x16_bf16((a), (b), (c), 0, 0, 0)
__device__ __forceinline__ bf16x8 ld8(const bf16* p) { return *(const GAS bf16x8*)p; }
__device__ __forceinline__ bf16x8 cvt8(const f32x16& v, int s) { v4u w; w.x = pk2(v[8 * s], v[8 * s + 1]); w.y = pk2(v[8 * s + 2], v[8 * s + 3]); w.z = pk2(v[8 * s + 4], v[8 * s + 5]); w.w = pk2(v[8 * s + 6], v[8 * s + 7]); return __builtin_bit_cast(bf16x8, w); }
__device__ __forceinline__ f32x16 zero16() { f32x16 z; for (int i = 0; i < 16; ++i) z[i] = 0.f; return z; }

__device__ __forceinline__ void fourier_unit(Frame& F, bool lat, int seq, int g, int pb) {
    const int L = lat ? 1024 : 256, rowbase = lat ? MC + seq * 1024 : seq * 256, r = F.lane & 31, h = F.lane >> 5;
    const bf16* YT = (const bf16*)(F.ws + WS_YT) + (lat ? (size_t)MC * 512 + (size_t)seq * 512 * 1024 : (size_t)seq * 512 * 256);
    const bf16* T = (const bf16*)(F.ws + (lat ? WS_T1024 : WS_T256));
    f32x16 acc[2][2]; acc[0][0] = zero16(); acc[0][1] = zero16(); acc[1][0] = zero16(); acc[1][1] = zero16();
    const bf16* ya = YT + (size_t)(g * 64 + r) * L + 8 * h;
    const bf16* tb = T + (size_t)(pb * 64 + r) * 2 * L + 8 * h;
    const int nks = 2 * L / 16;
#pragma unroll 4
    for (int ks = 0; ks < nks; ++ks) { const int k0 = 16 * ks, comp = k0 >= L, t0 = k0 - comp * L;
        const bf16x8 a0 = ld8(ya + (size_t)(comp * 256) * L + t0), a1 = ld8(ya + (size_t)(comp * 256 + 32) * L + t0);
        const bf16x8 b0 = ld8(tb + k0), b1 = ld8(tb + (size_t)32 * 2 * L + k0);
        acc[0][0] = MFMA32(a0, b0, acc[0][0]); acc[0][1] = MFMA32(a0, b1, acc[0][1]); acc[1][0] = MFMA32(a1, b0, acc[1][0]); acc[1][1] = MFMA32(a1, b1, acc[1][1]); }
    bf16* MX = (bf16*)(F.ws + WS_MIX);
#pragma unroll
    for (int ci = 0; ci < 2; ++ci)
#pragma unroll
        for (int pi = 0; pi < 2; ++pi) { bf16* o = MX + (size_t)(rowbase + pb * 64 + 32 * pi + r) * 1024 + g * 64 + 32 * ci + 4 * h;
#pragma unroll
            for (int gq = 0; gq < 4; ++gq) { u32x2 w; w.x = pk2(acc[ci][pi][4 * gq], acc[ci][pi][4 * gq + 1]); w.y = pk2(acc[ci][pi][4 * gq + 2], acc[ci][pi][4 * gq + 3]); *(GAS u32x2*)(o + 8 * gq) = w; } }
}

__device__ __forceinline__ void attn_unit(Frame& F, int l, bool lat, int seq, int hq, int qb) {
    const int L = lat ? 1024 : 256, rowbase = lat ? MC + seq * 1024 : seq * 256, r = F.lane & 31, h = F.lane >> 5, kvh = hq >> 2;
    const int cg0 = lat ? 256 + seq * 32 : seq * 8;
    const bf16* Z = (const bf16*)(F.ws + WS_Z);
    bf16x8 qf[4];
#pragma unroll
    for (int kk = 0; kk < 4; ++kk) qf[kk] = ld8(Z + (size_t)(rowbase + 32 * qb + r) * ZW + ZC_AQ + hq * 64 + 16 * kk + 8 * h);
    float m = KIN(22)[l * 8 + hq] * LOG2E, lsum = 1.0f;
    f32x16 ot[2]; ot[0] = zero16(); ot[1] = zero16();
    const int kb_lo = lat ? (qb - 4 < 0 ? 0 : qb - 4) : 0, kb_hi = lat ? (qb + 4 > 31 ? 31 : qb + 4) : 7;
    const int nloc = kb_hi - kb_lo + 1, ntile = nloc + (lat ? 16 : 0);
    const bf16* VTP = (const bf16*)(F.ws + WS_VTP);
    const bf16* KC = (const bf16*)(F.ws + WS_KC) + (((size_t)(seq * 2 + l) * 2 + kvh) * 512) * 64;
    const bf16* VCT = (const bf16*)(F.ws + WS_VCT) + (((size_t)(seq * 2 + l) * 2 + kvh) * 64) * 512;
    for (int ti = 0; ti < ntile; ++ti) {
        const bool loc = ti < nloc; const int kb = loc ? kb_lo + ti : ti - nloc;
        const bf16* kp = loc ? Z + (size_t)(rowbase + 32 * kb + r) * ZW + ZC_AK + kvh * 64 + 8 * h : KC + (size_t)(32 * kb + r) * 64 + 8 * h;
        const bf16* vp = loc ? VTP + ((size_t)(cg0 + kb) * 128 + kvh * 64 + r) * 32 + 8 * h : VCT + (size_t)r * 512 + 32 * kb + 8 * h;
        const size_t vstep = loc ? 32 * 32 : 32 * 512;
        bf16x8 kf[4], vf[2][2];
#pragma unroll
        for (int kk = 0; kk < 4; ++kk) kf[kk] = ld8(kp + 16 * kk);
#pragma unroll
        for (int tv = 0; tv < 2; ++tv)
#pragma unroll
            for (int s = 0; s < 2; ++s) vf[tv][s] = ld8(vp + tv * vstep + 16 * s);
        f32x16 st = zero16();
#pragma unroll
        for (int kk = 0; kk < 4; ++kk) st = MFMA32(kf[kk], qf[kk], st);
        if (lat && loc) { const int dq = 32 * qb + r - 32 * kb - 4 * h;
#pragma unroll
            for (int reg = 0; reg < 16; ++reg) { const int d = dq - ((reg & 3) + 8 * (reg >> 2)); if (d > 128 || d < -128) st[reg] = -INFINITY; } }
        float mx = st[0];
#pragma unroll
        for (int reg = 1; reg < 16; ++reg) mx = fmaxf(mx, st[reg]);
        mx = fmaxf(mx, __shfl_xor(mx, 32));
        const float mn = fmaxf(m, mx), alpha = ex2(m - mn); m = mn;
        float rs = 0.f;
#pragma unroll
        for (int reg = 0; reg < 16; ++reg) { st[reg] = ex2(st[reg] - mn); rs += st[reg]; }
        rs += __shfl_xor(rs, 32);
        lsum = lsum * alpha + rs;
#pragma unroll
        for (int reg = 0; reg < 16; ++reg) { ot[0][reg] *= alpha; ot[1][reg] *= alpha; }
        const bf16x8 p0 = cvt8(st, 0), p1 = cvt8(st, 1);
        ot[0] = MFMA32(vf[0][0], p0, ot[0]); ot[0] = MFMA32(vf[0][1], p1, ot[0]);
        ot[1] = MFMA32(vf[1][0], p0, ot[1]); ot[1] = MFMA32(vf[1][1], p1, ot[1]);
    }
    const float inv = 1.0f / lsum;
    bf16* o = (bf16*)(F.ws + WS_MIX) + (size_t)(rowbase + 32 * qb + r) * 1024 + 512 + hq * 64 + 4 * h;
#pragma unroll
    for (int tv = 0; tv < 2; ++tv)
#pragma unroll
        for (int gq = 0; gq < 4; ++gq) { u32x2 w; w.x = pk2(ot[tv][4 * gq] * inv, ot[tv][4 * gq + 1] * inv); w.y = pk2(ot[tv][4 * gq + 2] * inv, ot[tv][4 * gq + 3] * inv);
            *(GAS u32x2*)(o + 32 * tv + 8 * gq) = w; }
}

constexpr int HG_STAGE = 40 * 1024;
__device__ __forceinline__ void hgrn_unit(Frame& F, int l, bool lat, int seq, int hd) {
    const int L = lat ? 1024 : 256, rowbase = lat ? MC + seq * 1024 : seq * 256, r = F.lane & 31, h = F.lane >> 5;
    const int cg0 = lat ? 256 + seq * 32 : seq * 8, nch = L / 32;
    if (F.wave >= 4) {
        const int lw = F.wave - 4;
        const char* src[10];
#pragma unroll
        for (int i = 0; i < 10; ++i) { const int f = lw * 10 + i, dr = f / 20, q = f % 20;
            const size_t pb = ((size_t)(rowbase + r) * 2 + dr) * 256 + hd * 64 + 8 * h;
            const size_t cb = ((size_t)cg0 * 2 + dr) * 256 + hd * 64;
            const bf16* p;
            if (q < 4) p = (const bf16*)(F.ws + WS_KR) + pb + 16 * q;
            else if (q < 8) p = (const bf16*)(F.ws + WS_QR) + pb + 16 * (q - 4);
            else if (q < 12) p = (const bf16*)(F.ws + WS_QINP) + pb + 16 * (q - 8);
            else if (q < 16) p = (const bf16*)(F.ws + WS_KOUTT) + (cb + 32 * ((q - 12) >> 1) + r) * 32 + 16 * ((q - 12) & 1) + 8 * h;
            else p = (const bf16*)(F.ws + WS_VT) + (cb + 32 * ((q - 16) >> 1) + r) * 32 + 16 * ((q - 16) & 1) + 8 * h;
            src[i] = (const char*)p; }
#define HG_ISSUE(cs_) do { const unsigned sb_ = (unsigned)(((cs_) % 3) * HG_STAGE + lw * 10240); const size_t go_ = (size_t)(cs_) * 32768; \
        _Pragma("unroll") for (int i_ = 0; i_ < 10; ++i_) __builtin_amdgcn_global_load_lds((const unsigned*)(src[i_] + go_), (LAS unsigned*)(F.lds + sb_ + i_ * 1024), 16, 0, 0); } while (0)
        HG_ISSUE(0); HG_ISSUE(1);
        for (int cs = 0; cs < nch; ++cs) {
            if (cs + 1 < nch) asm volatile("s_waitcnt vmcnt(10)" ::: "memory"); else asm volatile("s_waitcnt vmcnt(0)" ::: "memory");
            __builtin_amdgcn_s_barrier(); asm volatile("" ::: "memory");
            if (cs + 2 < nch) HG_ISSUE(cs + 2);
        }
#undef HG_ISSUE
    } else {
        const int dr = F.wave >> 1, dvh = F.wave & 1;
        const float* EB = (const float*)(F.ws + WS_EB) + ((size_t)cg0 * 2 + dr) * 256 + hd * 64 + F.lane;
        bf16* OSC = (bf16*)(F.ws + WS_OSC);
        f32x16 S[2];
        if (lat) { const float* s0 = KIN(5) + ((((size_t)seq * 2 + l) * 2 + dr) * 4 + hd) * 4096;
#pragma unroll
            for (int t = 0; t < 2; ++t)
#pragma unroll
                for (int reg = 0; reg < 16; ++reg) S[t][reg] = s0[(32 * t + krow(reg, h)) * 64 + 32 * dvh + r]; }
        else { S[0] = zero16(); S[1] = zero16(); }
        float ebn = EB[0];
        for (int cs = 0; cs < nch; ++cs) {
            const float ebv = ebn; if (cs + 1 < nch) ebn = EB[(size_t)(cs + 1) * 512];
            __builtin_amdgcn_s_barrier(); asm volatile("" ::: "memory");
            const LAS unsigned char* sb = F.lds + (cs % 3) * HG_STAGE + dr * 20480 + F.lane * 16;
#define HG_FR(f_) (*(const LAS bf16x8*)(sb + (f_) * 1024))
            f32x16 a1 = zero16();
#pragma unroll
            for (int kk = 0; kk < 4; ++kk) a1 = MFMA32(HG_FR(kk), HG_FR(4 + kk), a1);
#pragma unroll
            for (int reg = 0; reg < 16; ++reg) if (krow(reg, h) > r) a1[reg] = 0.f;
            const bf16x8 vt0 = HG_FR(16 + dvh * 2), vt1 = HG_FR(17 + dvh * 2);
            f32x16 ot = zero16();
            ot = MFMA32(vt0, cvt8(a1, 0), ot); ot = MFMA32(vt1, cvt8(a1, 1), ot);
#pragma unroll
            for (int t = 0; t < 2; ++t)
#pragma unroll
                for (int s = 0; s < 2; ++s) ot = MFMA32(cvt8(S[t], s), HG_FR(8 + 2 * t + s), ot);
#pragma unroll
            for (int t = 0; t < 2; ++t) {
#pragma unroll
                for (int reg = 0; reg < 16; ++reg) S[t][reg] *= __shfl(ebv, 32 * t + krow(reg, h));
                S[t] = MFMA32(HG_FR(12 + 2 * t), vt0, S[t]); S[t] = MFMA32(HG_FR(13 + 2 * t), vt1, S[t]); }
#undef HG_FR
            const int tau = 32 * cs + r, tt = dr ? L - 1 - tau : tau;
            bf16* o = OSC + ((size_t)(rowbase + tt) * 2 + dr) * 256 + hd * 64 + 32 * dvh + 4 * h;
#pragma unroll
            for (int gq = 0; gq < 4; ++gq) { u32x2 w; w.x = pk2(ot[4 * gq], ot[4 * gq + 1]); w.y = pk2(ot[4 * gq + 2], ot[4 * gq + 3]); *(GAS u32x2*)(o + 8 * gq) = w; }
        }
        if (!lat) { float* so = F.out + OUT_ST + ((((size_t)seq * 2 + l) * 2 + dr) * 4 + hd) * 4096;
#pragma unroll
            for (int t = 0; t < 2; ++t)
#pragma unroll
                for (int reg = 0; reg < 16; ++reg) so[(32 * t + krow(reg, h)) * 64 + 32 * dvh + r] = S[t][reg]; }
    }
    VM_WAIT(); __syncthreads();
    const bf16* Z = (const bf16*)(F.ws + WS_Z); bf16* MX = (bf16*)(F.ws + WS_MIX); const bf16* OSC = (const bf16*)(F.ws + WS_OSC);
    for (int idx = F.tid; idx < L * 4; idx += 512) { const int q4 = idx & 3, t = idx >> 2, row = rowbase + t;
        float of[16], ob[16], gg[16];
        { const bf16* p = OSC + ((size_t)row * 2 + 0) * 256 + hd * 64 + 16 * q4; const v4u w0 = *(const GAS v4u*)p, w1 = *(const GAS v4u*)(p + 8);
          const unsigned ww[8] = {w0.x, w0.y, w0.z, w0.w, w1.x, w1.y, w1.z, w1.w};
#pragma unroll
          for (int j = 0; j < 8; ++j) { of[2 * j] = bf2f(ww[j] & 0xffffu); of[2 * j + 1] = bf2f(ww[j] >> 16); } }
        { const bf16* p = OSC + ((size_t)row * 2 + 1) * 256 + hd * 64 + 16 * q4; const v4u w0 = *(const GAS v4u*)p, w1 = *(const GAS v4u*)(p + 8);
          const unsigned ww[8] = {w0.x, w0.y, w0.z, w0.w, w1.x, w1.y, w1.z, w1.w};
#pragma unroll
          for (int j = 0; j < 8; ++j) { ob[2 * j] = bf2f(ww[j] & 0xffffu); ob[2 * j + 1] = bf2f(ww[j] >> 16); } }
        { const bf16* p = Z + (size_t)row * ZW + ZC_HG + hd * 64 + 16 * q4; const v4u w0 = *(const GAS v4u*)p, w1 = *(const GAS v4u*)(p + 8);
          const unsigned ww[8] = {w0.x, w0.y, w0.z, w0.w, w1.x, w1.y, w1.z, w1.w};
#pragma unroll
          for (int j = 0; j < 8; ++j) { gg[2 * j] = bf2f(ww[j] & 0xffffu); gg[2 * j + 1] = bf2f(ww[j] >> 16); } }
        float ss = 0.f;
#pragma unroll
        for (int j = 0; j < 16; ++j) { of[j] += ob[j]; ss += of[j] * of[j]; }
        ss += __shfl_xor(ss, 1); ss += __shfl_xor(ss, 2);
        const float rn = 1.0f / sqrtf(ss * (1.0f / 64.0f) + 1e-6f);
        const float* nw = KIN(19) + l * 256 + hd * 64 + 16 * q4;
        float res[16];
#pragma unroll
        for (int j = 0; j < 16; ++j) { const float g = gg[j]; res[j] = of[j] * rn * nw[j] * (g * __builtin_amdgcn_rcpf(1.0f + expf_fast(-g))); }
        bf16* o = MX + (size_t)row * 1024 + 256 + hd * 64 + 16 * q4;
        *(GAS bf16x8*)o = pack8(res); *(GAS bf16x8*)(o + 8) = pack8(res + 8);
    }
}
constexpr int MIX_ITEMS = 16 + 32 + 128 + 128 + 256 + 64;
__device__ __forceinline__ void mix_phase(Frame& F, int l, int qoff, int tmask = 7) {
    gu32* head = F.ctl + CW_Q + 64 * (l + qoff);
    for (;;) {
        if (F.tid == 0) F.MISC[16] = __hip_atomic_fetch_add(head, 1u, RLX_AGENT);
        __syncthreads();
        const int it = (int)F.MISC[16];
        __syncthreads();
        if (it >= MIX_ITEMS) break;
        int j = it;
        if (j < 16) { if (tmask & 1) hgrn_unit(F, l, true, j >> 2, j & 3); continue; } j -= 16;
        if (j < 32) { const int wu = j * 8 + F.wave; if (tmask & 2) fourier_unit(F, true, wu >> 6, (wu >> 4) & 3, wu & 15); continue; } j -= 32;
        if (j < 128) { if (tmask & 1) hgrn_unit(F, l, false, j >> 2, j & 3); continue; } j -= 128;
        if (j < 128) { if (tmask & 4) attn_unit(F, l, true, j >> 5, ((j >> 4) & 1) * 4 + (F.wave & 3), (j & 15) * 2 + (F.wave >> 2)); continue; } j -= 128;
        if (j < 256) { if (tmask & 4) attn_unit(F, l, false, j >> 3, ((j >> 2) & 1) * 4 + (F.wave & 3), (j & 3) * 2 + (F.wave >> 2)); continue; } j -= 256;
        { const int wu = j * 8 + F.wave; if (tmask & 2) fourier_unit(F, false, wu >> 4, (wu >> 2) & 3, wu & 3); }
    }
}

#ifndef PH
#define PH 0xffff
#endif
#ifndef PROBE
#define PROBE 0
#endif
struct Args { const float* in[23]; float* out; unsigned char* ws; };
__global__ void __launch_bounds__(NWAVES * 64, 2) fwd_kernel(Args args) {
    extern __shared__ __attribute__((aligned(16))) unsigned char lds[];
    Frame F;
    F.lds = (LAS unsigned char*)lds; F.MISC = (volatile LAS unsigned*)(F.lds + MISC_OFF);
    F.tid = threadIdx.x; F.lane = F.tid & 63; F.wave = __builtin_amdgcn_readfirstlane(F.tid >> 6); F.G = gridDim.x;
    F.out = args.out; F.ws = args.ws; F.ctl = (gu32*)(args.ws + WS_CTL);
    for (int u = F.tid; u < (LDS_BYTES - LDSCTL_OFF) / 4; u += NWAVES * 64) ((LAS unsigned*)(F.lds + LDSCTL_OFF))[u] = 0u;
    __syncthreads();
    XcdBarrier bar = xcd_barrier_post((unsigned*)(F.ctl + CW_BAR), F.MISC + 8);
#define GRID_BAR() do { xcd_barrier(bar); TID_REFRESH(); } while (0)
#define TID_REFRESH() do { int t_ = threadIdx.x; asm volatile("" : "+v"(t_)); F.tid = t_; F.lane = t_ & 63; F.wave = __builtin_amdgcn_readfirstlane(t_ >> 6); } while (0)
    bf16* H = (bf16*)(F.ws + WS_H); bf16* ACT = (bf16*)(F.ws + WS_ACT); bf16* ZB = (bf16*)(F.ws + WS_Z); bf16* MX = (bf16*)(F.ws + WS_MIX);
    float* X = F.out;

#if PH & 1
    p0_prologue(F); GRID_BAR();
#if PROBE == 2
    p0_prologue(F); GRID_BAR();
#endif
#endif
#if PH & 2
    p0b_modtables(F); GRID_BAR();
#endif
#pragma nounroll
    for (int step = 0; step < 6; ++step) {
        const int l = step / 3, part = step - 3 * l;
        if (part != 1) {
            const int f = part >> 1, k = 2 * f; const bool first = step == 0;
            const float* xs0 = first ? KIN(0) : X; const float* xs1 = first ? KIN(1) - (size_t)MC * D : X;
#if PH & 4
            norm_phase(F, xs0, xs1, mod_tab(F, 0, l, k), mod_tab(F, 1, l, k)); GRID_BAR();
#if PROBE == 3
            norm_phase(F, xs0, xs1, mod_tab(F, 0, l, k), mod_tab(F, 1, l, k)); GRID_BAR();
#endif
#endif
#if PH & 8
            { pg8::Gemm g{H, (const bf16*)(F.ws + WS_WGU + (size_t)(l * 2 + f) * WGU_SZ), M, NGU, D}; pg8::StaticOrder S; S.init(M, NGU, F.G, (int)blockIdx.x);
              pg8::EpiSwiglu E{ACT, FF}; pg8::gemm_phase<pg8::EpiSwiglu, pg8::StaticOrder, true, true>(F.lds, g, S, E, F.tid); } GRID_BAR();
#endif
#if PH & 16
            { pg8::Gemm g{ACT, (const bf16*)(F.ws + WS_WDN + (size_t)(l * 2 + f) * WDN_SZ), M, D, FF}; pg8::StaticOrder S; S.init(M, D, F.G, (int)blockIdx.x);
              pg8::EpiRes E{xs0, xs1, X, mod_tab(F, 2, l, k)}; pg8::gemm_phase<pg8::EpiRes, pg8::StaticOrder, true, true>(F.lds, g, S, E, F.tid); }
            if (step != 5) GRID_BAR();
#endif
        } else {
#if PH & 4
            norm_phase(F, X, X, mod_tab(F, 0, l, 1), mod_tab(F, 1, l, 1)); GRID_BAR();
#if PROBE == 3
            norm_phase(F, X, X, mod_tab(F, 0, l, 1), mod_tab(F, 1, l, 1)); GRID_BAR();
#endif
#endif
#if PH & 32
            { pg8::Gemm g{H, (const bf16*)(F.ws + WS_WIN + (size_t)l * WIN_SZ), M, ZW, D}; pg8::StaticOrder S; S.init(M, ZW, F.G, (int)blockIdx.x);
              pg8::EpiBf16<0> E{ZB, ZW, nullptr, 0, 0, 1.f}; pg8::gemm_phase<pg8::EpiBf16<0>, pg8::StaticOrder, true, true>(F.lds, g, S, E, F.tid); } GRID_BAR();
#endif
#if PH & 64
            prep_phase(F, l); GRID_BAR();
#endif
#if PH & 128
            mix_phase(F, l, 0); GRID_BAR();
#if PROBE == 1
            mix_phase(F, l, 2); GRID_BAR();
#endif
#if PROBE >= 11 && PROBE <= 14
            mix_phase(F, l, 2, PROBE == 11 ? 1 : PROBE == 12 ? 2 : PROBE == 13 ? 4 : 0); GRID_BAR();
#endif
#if PROBE == 5
            for (int e = 0; e < 10; ++e) GRID_BAR();
#endif
#endif
#if PH & 256
            { pg8::Gemm g{MX, (const bf16*)(F.ws + WS_WOUT + (size_t)l * WOUT_SZ), M, D, D}; pg8::StaticOrder S; S.init(M, D, F.G, (int)blockIdx.x);
              pg8::EpiRes E{X, X, X, mod_tab(F, 2, l, 1)}; pg8::gemm_phase<pg8::EpiRes, pg8::StaticOrder, true, true>(F.lds, g, S, E, F.tid); } GRID_BAR();
#endif
        }
    }
}

extern "C" void kernel_launch(void* const* d_in, const int* in_sizes, int n_in, void* d_out, int out_size, void* d_ws, size_t ws_size, hipStream_t stream) {
    static int grid = 0;
    if (grid == 0) {
        if (n_in != 23 || out_size != OUT_TOTAL || ws_size < WS_END) { fprintf(stderr, "kernel_launch: unexpected shapes (n_in %d, out %d, ws %zu)\n", n_in, out_size, ws_size); grid = -1; return; }
        int dev = 0, cus = 0;
        if (hipGetDevice(&dev) != hipSuccess || hipDeviceGetAttribute(&cus, hipDeviceAttributeMultiprocessorCount, dev) != hipSuccess) { grid = -1; return; }
        if (hipFuncSetAttribute((const void*)fwd_kernel, hipFuncAttributeMaxDynamicSharedMemorySize, LDS_BYTES) != hipSuccess) { fprintf(stderr, "kernel_launch: hipFuncSetAttribute failed\n"); grid = -1; return; }
        (void)hipGetLastError();
        grid = cus;
    }
    if (grid < 0) return;
    if (hipMemsetAsync((char*)d_ws + WS_CTL, 0, CTL_ZERO_BYTES, stream) != hipSuccess) return;
    Args a{};
    for (int i = 0; i < 23; ++i) a.in[i] = (const float*)d_in[i];
    a.out = (float*)d_out; a.ws = (unsigned char*)d_ws;
    hipLaunchKernelGGL(fwd_kernel, dim3(grid), dim3(NWAVES * 64), LDS_BYTES, stream, a);
}
```

```cpp
#include <hip/hip_runtime.h>
#include <cstdio>
#include <cstdint>
namespace pg8 {
#define PG8_LAS __attribute__((address_space(3)))
typedef unsigned short bf16_t;
typedef short bf16x8 __attribute__((ext_vector_type(8)));
typedef float f32x4 __attribute__((ext_vector_type(4)));
typedef unsigned u32x4 __attribute__((ext_vector_type(4)));
constexpr int BM = 256, BK = 64, HALF = 128, HTB = HALF * BK * 2  , STAGE_BYTES = 8 * HTB, NXCD = 8, WGM = 8;

__host__ __device__ __forceinline__ int lds_byte(int r, int c) { const int st = (r >> 4) * 2 + (c >> 5), rr = r & 15, cc = c & 31, ob = rr * 64 + cc * 2; return st * 1024 + (ob ^ (((ob >> 9) & 1) << 5)); }
__host__ __device__ __forceinline__ void stage_rc(int b, int& R, int& C) { const int st = b / 1024, sb = b % 1024, swz = sb ^ (((sb >> 9) & 1) << 5); R = (st >> 1) * 16 + swz / 64; C = (st & 1) * 32 + (swz % 64) / 2; }
__host__ __device__ __forceinline__ int perm32(int rho) { const int n = rho >> 4, i = rho & 15; return 8 * (i >> 2) + 4 * n + (i & 3); }

struct Unit { int pm, pn; };
struct Gemm { const bf16_t* A; const bf16_t* Bt; int M, N, K; };

struct StaticOrder {
    int nM, nN, nwg, G, c;
    __host__ __device__ void init(int M, int N, int G_, int c_) { nM = M / BM; nN = N / BM; nwg = nM * nN; G = G_; c = c_; }
    __host__ __device__ bool next(int i, Unit& u) const {
        const long L = (long)i * G + c; if (L >= nwg) return false;
        int wgid = (int)L; { const int q = nwg / NXCD, r = nwg % NXCD, xcd = wgid % NXCD, off = wgid / NXCD; wgid = (xcd < r ? xcd * (q + 1) : r * (q + 1) + (xcd - r) * q) + off; }
        const int nig = WGM * nN, gid = wgid / nig, fm = gid * WGM, gsz = (nM - fm) < WGM ? (nM - fm) : WGM;
        u.pm = fm + ((wgid % nig) % gsz); u.pn = (wgid % nig) / gsz; return true;
    }
    __device__ __forceinline__ void a_ready(const Unit&) const {}
    __device__ __forceinline__ void done(const Unit&) const {}
};

__device__ __forceinline__ unsigned cvt_pk_bf16(float lo, float hi) { unsigned r; asm volatile("v_cvt_pk_bf16_f32 %0, %1, %2" : "=v"(r) : "v"(lo), "v"(hi)); return r; }
typedef float f32x2 __attribute__((ext_vector_type(2)));
__device__ __forceinline__ f32x2 gelu_pk(f32x2 v) {
    const f32x2 av = __builtin_elementwise_abs(v), d = av * 0.2316418882f + 1.0f;
    f32x2 t; t.x = __builtin_amdgcn_rcpf(d.x); t.y = __builtin_amdgcn_rcpf(d.y);
    f32x2 q = t * 0.5307027145f + (-0.7265760135f); q = q * t + 0.7107068705f; q = q * t + (-0.142248368f); q = q * t + 0.127414796f; q = q * t;
    const f32x2 s = (v * v) * (-0.72134752044f);
    f32x2 e; e.x = __builtin_amdgcn_exp2f(s.x); e.y = __builtin_amdgcn_exp2f(s.y);
    const f32x2 m = v * (q * e), r = v - m;
    f32x2 o; o.x = v.x < 0.f ? m.x : r.x; o.y = v.y < 0.f ? m.y : r.y; return o;
}

template <int ACT  > struct EpiBf16 {
    static constexpr bool PERM = true, AFTER_DRAIN = false; static_assert(ACT == 0 || ACT == 1, "EpiBf16: ACT is 0 (none) or 1 (gelu_pk)");
    bf16_t* O; int ldc; const float* bias; int split_cols; size_t split_stride; float scale0;
    __device__ __forceinline__ void operator()(const f32x4 (&acc)[2][2][4][2], const Unit& u, int wr, int wc, int fr, int fq) const {
        const int row0 = u.pm * BM + wr * 64 + fr; int colt = u.pn * BM; bf16_t* base = O;
        float sc = 1.f; if (split_cols) { const int t = colt / split_cols; base += (size_t)t * split_stride; colt -= t * split_cols; if (t == 0) sc = scale0; }
        const int col0 = colt + wc * 32 + 8 * fq, bcol0 = u.pn * BM + wc * 32 + 8 * fq;
        f32x4 bv[2][2];
#pragma unroll
        for (int bj = 0; bj < 2; ++bj)
#pragma unroll
            for (int n = 0; n < 2; ++n) bv[bj][n] = bias ? *(const f32x4*)(bias + bcol0 + bj * HALF + 4 * n) : (f32x4){0.f, 0.f, 0.f, 0.f};
#pragma unroll
        for (int ai = 0; ai < 2; ++ai)
#pragma unroll
            for (int m = 0; m < 4; ++m) { bf16_t* rowp = base + (size_t)(row0 + ai * HALF + m * 16) * ldc + col0;
#pragma unroll
                for (int bj = 0; bj < 2; ++bj) { f32x4 v0 = acc[ai][bj][m][0] + bv[bj][0], v1 = acc[ai][bj][m][1] + bv[bj][1];
                    if (ACT == 1) { f32x2 a = gelu_pk((f32x2){v0[0], v0[1]}), b = gelu_pk((f32x2){v0[2], v0[3]}), c = gelu_pk((f32x2){v1[0], v1[1]}), d = gelu_pk((f32x2){v1[2], v1[3]});
                        v0 = (f32x4){a.x, a.y, b.x, b.y}; v1 = (f32x4){c.x, c.y, d.x, d.y}; }
                    v0 = v0 * sc; v1 = v1 * sc; u32x4 w; w.x = cvt_pk_bf16(v0[0], v0[1]); w.y = cvt_pk_bf16(v0[2], v0[3]); w.z = cvt_pk_bf16(v1[0], v1[1]); w.w = cvt_pk_bf16(v1[2], v1[3]);
                    *(u32x4*)(rowp + bj * HALF) = w; } }
    }
};
struct EpiSwiglu {
    static constexpr bool PERM = true, AFTER_DRAIN = false;
    bf16_t* O; int ldc;
    __device__ __forceinline__ void operator()(const f32x4 (&acc)[2][2][4][2], const Unit& u, int wr, int wc, int fr, int fq) const {
        const int row0 = u.pm * BM + wr * 64 + fr; const int col0 = u.pn * HALF + wc * 32 + 8 * fq;
#pragma unroll
        for (int ai = 0; ai < 2; ++ai)
#pragma unroll
            for (int m = 0; m < 4; ++m) { bf16_t* rowp = O + (size_t)(row0 + ai * HALF + m * 16) * ldc + col0;
                float a[8];
#pragma unroll
                for (int n = 0; n < 2; ++n)
#pragma unroll
                    for (int i = 0; i < 4; ++i) { const float g = acc[ai][0][m][n][i], uu = acc[ai][1][m][n][i];
                        const float sg = g * __builtin_amdgcn_rcpf(1.0f + __builtin_amdgcn_exp2f(-1.4426950408889634f * g)); a[n * 4 + i] = sg * uu; }
                u32x4 w; w.x = cvt_pk_bf16(a[0], a[1]); w.y = cvt_pk_bf16(a[2], a[3]); w.z = cvt_pk_bf16(a[4], a[5]); w.w = cvt_pk_bf16(a[6], a[7]);
                *(u32x4*)rowp = w; }
    }
};
struct EpiRes {
    static constexpr bool PERM = false, AFTER_DRAIN = false;
    const float* base0; const float* base1; float* out; const float* gate;
    __device__ __forceinline__ void operator()(const f32x4 (&acc)[2][2][4][2], const Unit& u, int wr, int wc, int fr, int fq) const {
        const int col0 = u.pn * BM + wc * 32 + 4 * fq; const int cond = u.pm < 32 ? 0 : 1 + ((u.pm - 32) >> 2);
        const float* base = u.pm < 32 ? base0 : base1;
        f32x4 gv[2][2];
#pragma unroll
        for (int bj = 0; bj < 2; ++bj)
#pragma unroll
            for (int n = 0; n < 2; ++n) gv[bj][n] = *(const f32x4*)(gate + cond * 1024 + col0 + bj * HALF + n * 16);
#pragma unroll
        for (int ai = 0; ai < 2; ++ai)
#pragma unroll
            for (int m = 0; m < 4; ++m) { const size_t off = (size_t)(u.pm * BM + ai * HALF + wr * 64 + m * 16 + fr) * 1024 + col0;
#pragma unroll
                for (int bj = 0; bj < 2; ++bj)
#pragma unroll
                    for (int n = 0; n < 2; ++n) { const f32x4 bs = *(const f32x4*)(base + off + bj * HALF + n * 16);
                        *(f32x4*)(out + off + bj * HALF + n * 16) = bs + gv[bj][n] * acc[ai][bj][m][n]; } }
    }
};
template <class Epi, class Sched, bool ALIGN_EPI = false, bool SP2 = false>
__device__ __forceinline__ void gemm_phase(PG8_LAS unsigned char* lds, const Gemm g, const Sched& S, const Epi& E, int tid_in) {
    const int tid = tid_in, wid = __builtin_amdgcn_readfirstlane(tid >> 6), lane = tid & 63, wr = wid >> 2, wc = wid & 3, fr = lane & 15, fq = lane >> 4;
    const int K = g.K, nt = K / BK;
    unsigned voffA[2], voffB[2];
#pragma unroll
    for (int i = 0; i < 2; ++i) { int R, C; stage_rc(tid * 16 + i * 8192, R, C); const int Rb = Epi::PERM ? ((R & ~31) + perm32(R & 31)) : R;
        voffA[i] = (unsigned)(R * K + C) * 2u; voffB[i] = (unsigned)(Rb * K + C) * 2u; }
    const size_t kstep = (size_t)(BK * 2);
    const size_t hstep = (size_t)HALF * K * 2;
    const size_t tstep = 2 * hstep;
    const unsigned ldsw = (unsigned)wid * 1024u;
    const int aoff = lds_byte(wr * 64 + fr, fq * 8), boff = lds_byte(wc * 32 + fr, fq * 8);
#define PG8_SA(b, h) (((b) * 2 + (h)) * HTB)
#define PG8_SB(b, h) ((4 + (b) * 2 + (h)) * HTB)
#define PG8_STAGE(bufoff, gbase, voff) do { _Pragma("unroll") for (int _i = 0; _i < 2; ++_i) \
        __builtin_amdgcn_global_load_lds((const unsigned*)((const char*)(gbase) + (voff)[_i]), (PG8_LAS unsigned*)(lds + (bufoff) + ldsw + _i * 8192), 16, 0, 0); } while (0)
#define PG8_LDA(dst, b, h) do { _Pragma("unroll") for (int m = 0; m < 4; ++m) _Pragma("unroll") for (int k = 0; k < 2; ++k) dst[m][k] = *(const PG8_LAS bf16x8*)(lds + PG8_SA(b, h) + aoff + m * 2048 + k * 1024); } while (0)
#define PG8_LDB(dst, b, h) do { _Pragma("unroll") for (int n = 0; n < 2; ++n) _Pragma("unroll") for (int k = 0; k < 2; ++k) dst[n][k] = *(const PG8_LAS bf16x8*)(lds + PG8_SB(b, h) + boff + n * 2048 + k * 1024); } while (0)
#define PG8_MMA(ai, bj, At, Bt) do { __builtin_amdgcn_s_setprio(1); _Pragma("unroll") for (int m = 0; m < 4; ++m) _Pragma("unroll") for (int n = 0; n < 2; ++n) _Pragma("unroll") for (int k = 0; k < 2; ++k) \
        acc[ai][bj][m][n] = __builtin_amdgcn_mfma_f32_16x16x32_bf16(Bt[n][k], At[m][k], acc[ai][bj][m][n], 0, 0, 0); __builtin_amdgcn_s_setprio(0); } while (0)
#define PG8_WAIT_V(n) asm volatile("s_waitcnt vmcnt(" #n ")" ::: "memory")
#define PG8_WAIT_L(n) asm volatile("s_waitcnt lgkmcnt(" #n ")" ::: "memory")
#define PG8_BAR __builtin_amdgcn_s_barrier()
#define PG8_SCHED __builtin_amdgcn_sched_barrier(0)
    Unit cur, nxt; int ui = 0;
    if (!S.next(0, cur)) return;
    f32x4 acc[2][2][4][2];
#pragma unroll
    for (int a = 0; a < 2; ++a)
#pragma unroll
        for (int b = 0; b < 2; ++b)
#pragma unroll
            for (int m = 0; m < 4; ++m)
#pragma unroll
                for (int n = 0; n < 2; ++n) acc[a][b][m][n] = (f32x4){0.f, 0.f, 0.f, 0.f};
    bf16x8 At[4][2], B0[2][2], B1[2][2];
    const char* cA = (const char*)g.A + (size_t)cur.pm * tstep; const char* cB = (const char*)g.Bt + (size_t)cur.pn * tstep;
    S.a_ready(cur);
    if constexpr (SP2) {
        PG8_STAGE(PG8_SB(0, 0), cB, voffB); PG8_STAGE(PG8_SB(0, 1), cB + hstep, voffB); PG8_STAGE(PG8_SA(0, 0), cA, voffA); PG8_STAGE(PG8_SA(0, 1), cA + hstep, voffA);
        if (wr == 1) PG8_BAR;
        PG8_WAIT_V(2); PG8_BAR;
        PG8_STAGE(PG8_SB(1, 0), cB + kstep, voffB); PG8_STAGE(PG8_SA(1, 0), cA + kstep, voffA); PG8_STAGE(PG8_SB(1, 1), cB + hstep + kstep, voffB);
        PG8_WAIT_V(6); PG8_BAR;
    } else {
        PG8_STAGE(PG8_SB(0, 0), cB, voffB); PG8_STAGE(PG8_SA(0, 0), cA, voffA); PG8_STAGE(PG8_SB(0, 1), cB + hstep, voffB); PG8_STAGE(PG8_SA(0, 1), cA + hstep, voffA);
        if (wr == 1) PG8_BAR;
        PG8_WAIT_V(4); PG8_BAR;
        PG8_STAGE(PG8_SB(1, 0), cB + kstep, voffB); PG8_STAGE(PG8_SA(1, 0), cA + kstep, voffA); PG8_STAGE(PG8_SB(1, 1), cB + hstep + kstep, voffB);
        PG8_WAIT_V(6); PG8_BAR;
    }
    for (;;) {
        const bool has_next = S.next(ui + 1, nxt);
        const char* nA = has_next ? (const char*)g.A + (size_t)nxt.pm * tstep : cA; const char* nB = has_next ? (const char*)g.Bt + (size_t)nxt.pn * tstep : cB;
        for (int t = 0; t < nt; t += 2) {
            const bool last = (t == nt - 2);
            const char* a1 = cA + (size_t)(t + 1) * kstep;
            const char* a2 = last ? nA : cA + (size_t)(t + 2) * kstep; const char* b2 = last ? nB : cB + (size_t)(t + 2) * kstep;
            const char* a3 = a2 + kstep; const char* b3 = b2 + kstep;
            if (last && has_next) S.a_ready(nxt);
            if constexpr (SP2) {
            PG8_LDB(B0, 0, 0); PG8_LDB(B1, 0, 1); PG8_SCHED; PG8_LDA(At, 0, 0); PG8_STAGE(PG8_SA(1, 1), a1 + hstep, voffA);
            PG8_WAIT_V(8); PG8_WAIT_L(0); PG8_BAR; PG8_MMA(0, 0, At, B0); PG8_MMA(0, 1, At, B1); PG8_BAR; PG8_SCHED;
            PG8_LDA(At, 0, 1); PG8_STAGE(PG8_SB(0, 0), b2, voffB); PG8_STAGE(PG8_SB(0, 1), b2 + hstep, voffB); PG8_STAGE(PG8_SA(0, 0), a2, voffA);
            PG8_WAIT_V(8); PG8_WAIT_L(0); PG8_BAR; PG8_MMA(1, 0, At, B0); PG8_MMA(1, 1, At, B1); PG8_BAR; PG8_SCHED;
            PG8_LDB(B0, 1, 0); PG8_LDB(B1, 1, 1); PG8_SCHED; PG8_LDA(At, 1, 0); PG8_STAGE(PG8_SA(0, 1), a2 + hstep, voffA);
            PG8_WAIT_V(8); PG8_WAIT_L(0); PG8_BAR; PG8_MMA(0, 0, At, B0); PG8_MMA(0, 1, At, B1); PG8_BAR; PG8_SCHED;
            PG8_LDA(At, 1, 1); PG8_STAGE(PG8_SB(1, 0), b3, voffB); PG8_STAGE(PG8_SB(1, 1), b3 + hstep, voffB); PG8_STAGE(PG8_SA(1, 0), a3, voffA);
            PG8_WAIT_V(8); PG8_WAIT_L(0); PG8_BAR; PG8_MMA(1, 0, At, B0); PG8_MMA(1, 1, At, B1); PG8_BAR; PG8_SCHED;
            } else {
            PG8_LDB(B0, 0, 0); PG8_SCHED; PG8_LDA(At, 0, 0); PG8_STAGE(PG8_SA(1, 1), a1 + hstep, voffA);
            PG8_WAIT_L(8); PG8_BAR; PG8_WAIT_L(0); PG8_MMA(0, 0, At, B0); PG8_BAR; PG8_SCHED;
            PG8_LDB(B1, 0, 1); PG8_STAGE(PG8_SB(0, 0), b2, voffB);
            PG8_BAR; PG8_WAIT_L(0); PG8_MMA(0, 1, At, B1); PG8_BAR;
            PG8_LDA(At, 0, 1); PG8_STAGE(PG8_SA(0, 0), a2, voffA);
            PG8_BAR; PG8_WAIT_L(0); PG8_MMA(1, 0, At, B0); PG8_BAR; PG8_SCHED;
            PG8_STAGE(PG8_SB(0, 1), b2 + hstep, voffB);
            PG8_WAIT_V(6); PG8_BAR; PG8_MMA(1, 1, At, B1); PG8_BAR;
            PG8_LDB(B0, 1, 0); PG8_SCHED; PG8_LDA(At, 1, 0); PG8_STAGE(PG8_SA(0, 1), a2 + hstep, voffA);
            PG8_WAIT_L(8); PG8_BAR; PG8_WAIT_L(0); PG8_MMA(0, 0, At, B0); PG8_BAR; PG8_SCHED;
            PG8_LDB(B1, 1, 1); PG8_STAGE(PG8_SB(1, 0), b3, voffB);
            PG8_BAR; PG8_WAIT_L(0); PG8_MMA(0, 1, At, B1); PG8_BAR;
            PG8_LDA(At, 1, 1); PG8_STAGE(PG8_SA(1, 0), a3, voffA);
            PG8_BAR; PG8_WAIT_L(0); PG8_MMA(1, 0, At, B0); PG8_BAR; PG8_SCHED;
            PG8_STAGE(PG8_SB(1, 1), b3 + hstep, voffB);
            PG8_WAIT_V(6); PG8_BAR; PG8_MMA(1, 1, At, B1); PG8_BAR;
            }
        }
        if constexpr (ALIGN_EPI) { if (wr == 0) PG8_BAR; }
        if constexpr (!Epi::AFTER_DRAIN) { E(acc, cur, wr, wc, fr, fq); S.done(cur); }
        if (!has_next) break;
#pragma unroll
        for (int a = 0; a < 2; ++a)
#pragma unroll
            for (int b = 0; b < 2; ++b)
#pragma unroll
                for (int m = 0; m < 4; ++m)
#pragma unroll
                    for (int n = 0; n < 2; ++n) acc[a][b][m][n] = (f32x4){0.f, 0.f, 0.f, 0.f};
        cur = nxt; cA = nA; cB = nB; ++ui;
        if constexpr (ALIGN_EPI) { if (wr == 1) PG8_BAR; }
    }
    PG8_WAIT_V(0);
    if constexpr (!ALIGN_EPI) { if (wr == 0) PG8_BAR; }
    PG8_BAR;
    if constexpr (Epi::AFTER_DRAIN) { E.fused(acc, cur, wr, wc, fr, fq, lds, wid, lane); S.done(cur); }
#undef PG8_SA
#undef PG8_SB
#undef PG8_STAGE
#undef PG8_LDA
#undef PG8_LDB
#undef PG8_MMA
#undef PG8_WAIT_V
#undef PG8_WAIT_L
#undef PG8_BAR
#undef PG8_SCHED
}
}
#define GAS __attribute__((address_space(1)))
#define LAS __attribute__((address_space(3)))
typedef unsigned short bf16;
typedef unsigned v4u __attribute__((ext_vector_type(4)));
typedef float f32x4 __attribute__((ext_vector_type(4)));
typedef short bf16x8 __attribute__((ext_vector_type(8)));
typedef GAS unsigned gu32;
typedef GAS unsigned long long gu64;
#define RLX_AGENT __ATOMIC_RELAXED, __HIP_MEMORY_SCOPE_AGENT
#define LDS_WAIT() asm volatile("s_waitcnt lgkmcnt(0)" ::: "memory")
#define VM_WAIT() asm volatile("s_waitcnt vmcnt(0)" ::: "memory")
__device__ __forceinline__ unsigned long long rt() { return __builtin_amdgcn_s_memrealtime(); }
__device__ __forceinline__ unsigned f2bf(float f) { unsigned u = __builtin_bit_cast(unsigned, f); return (u + 0x7fffu + ((u >> 16) & 1u)) >> 16; }
__device__ __forceinline__ unsigned pk2(float lo, float hi) { return f2bf(lo) | (f2bf(hi) << 16); }

#define XB_TMO      128
#define XB_XCNT(j)  (256  + 64 * (j))
#define XB_XSUB(j)  (1280 + 64 * (j))
#define XB_XGEN(j)  (2304 + 64 * (j))
#define XB_TOP      3328
#define XB_TOPGEN   3392
#define XCD_BAR_WORDS 3456
#define XB_SPIN_CAP (1u << 18)

__device__ __forceinline__ unsigned xb_ld(unsigned* p)              { return __hip_atomic_load(p, __ATOMIC_RELAXED, __HIP_MEMORY_SCOPE_AGENT); }
__device__ __forceinline__ unsigned xb_add(unsigned* p, unsigned v) { return __hip_atomic_fetch_add(p, v, __ATOMIC_RELAXED, __HIP_MEMORY_SCOPE_AGENT); }
__device__ __forceinline__ unsigned xb_xcc_id() { return (unsigned)__builtin_amdgcn_s_getreg((3 << 11) | 20) & 0xFu; }
#define XB_SPIN(cond, bar) do { unsigned _sp = 0; while (cond) { __builtin_amdgcn_s_sleep(1); \
    if ((++_sp & 255u) == 0u) { if (xb_ld(&(bar)[XB_TMO])) break; if (_sp > XB_SPIN_CAP) { atomicAdd(&(bar)[XB_TMO], 1u); break; } } } } while (0)

struct XcdBarrier {
    unsigned* bar; unsigned x;
    volatile LAS unsigned* st;
};

__device__ __forceinline__ XcdBarrier xcd_barrier_post(unsigned* bar, volatile LAS unsigned* st) {
    XcdBarrier b; b.bar = bar; b.x = xb_xcc_id(); b.st = st;
    if (threadIdx.x == 0) (void)xb_add(&bar[XB_XCNT(b.x)], 1u);
    return b;
}
__device__ __forceinline__ void xcd_barrier_complete(unsigned* bar, unsigned x, unsigned& nloc, unsigned& nx) {
    const unsigned G = gridDim.x * gridDim.y * gridDim.z;
    unsigned sum, cnt, mine, sp = 0u;
    for (;;) {
        sum = 0u; cnt = 0u; mine = 0u;
#pragma unroll
        for (unsigned j = 0; j < 16; ++j) { const unsigned c = xb_ld(&bar[XB_XCNT(j)]); sum += c; cnt += (c > 0u) ? 1u : 0u; mine = (j == x) ? c : mine; }
        if (sum == G) break;
        __builtin_amdgcn_s_sleep(1);
        if ((++sp & 255u) == 0u) { if (xb_ld(&bar[XB_TMO])) break; if (sp > XB_SPIN_CAP) { atomicAdd(&bar[XB_TMO], 1u); break; } }
    }
    nloc = mine > 0u ? mine : 1u; nx = cnt > 0u ? cnt : 1u;
}

__device__ __forceinline__ void xcd_barrier(const XcdBarrier& b) {
    asm volatile("s_waitcnt vmcnt(0)" ::: "memory");
    __syncthreads();
    if (threadIdx.x == 0) {
        unsigned* bar = b.bar;
        __builtin_amdgcn_s_waitcnt(0);
        unsigned nloc = b.st[0], nx = b.st[1];
        if (nloc == 0u) { xcd_barrier_complete(bar, b.x, nloc, nx); b.st[0] = nloc; b.st[1] = nx; }
        const unsigned old = xb_add(&bar[XB_XSUB(b.x)], 1u);
        const unsigned gen = old / nloc;
        if (old + 1u == (gen + 1u) * nloc) {
            __builtin_amdgcn_fence(__ATOMIC_RELEASE, "agent");
            asm volatile("s_waitcnt vmcnt(0)" ::: "memory");
            const unsigned og = xb_add(&bar[XB_TOP], 1u);
            const unsigned tg = og / nx;
            if (og + 1u == (tg + 1u) * nx) xb_add(&bar[XB_TOPGEN], 1u);
            else XB_SPIN(xb_ld(&bar[XB_TOPGEN]) == tg, bar);
            __builtin_amdgcn_fence(__ATOMIC_ACQUIRE, "agent");
            xb_add(&bar[XB_XGEN(b.x)], 1u);
            asm volatile("s_waitcnt vmcnt(0)" ::: "memory");
        } else {
            XB_SPIN(xb_ld(&bar[XB_XGEN(b.x)]) == gen, bar);
            __builtin_amdgcn_fence(__ATOMIC_ACQUIRE, "agent");
            asm volatile("s_waitcnt vmcnt(0)" ::: "memory");
        }
    }
    __syncthreads();
}

constexpr int NWAVES = 8;
constexpr int D = 1024, M = 12288, MC = 8192, FF = 2816, NGU = 5632, ZW = 2560;
constexpr int ZC_Y = 0, ZC_HQ = 512, ZC_HI = 768, ZC_HFF = 1024, ZC_HFB = 1280, ZC_HG = 1536, ZC_AQ = 1792, ZC_AK = 2304, ZC_AV = 2432;
constexpr int NCHUNK = M / 32;
constexpr float QSCALE = 0.125f * 1.4426950408889634f;
constexpr float LOG2E = 1.4426950408889634f;
constexpr size_t MiB = 1u << 20;
constexpr size_t WS_CTL = 0, CTL_ZERO_BYTES = 1 * MiB;
constexpr size_t WS_MODP = 1 * MiB;
constexpr size_t WS_MODT = 7 * MiB;
constexpr size_t WS_T1024 = 8 * MiB, WS_T256 = 12 * MiB;
constexpr size_t WS_KC = 13 * MiB, WS_VCT = 14 * MiB;
constexpr size_t WS_WGU = 16 * MiB, WGU_SZ = 11 * MiB;
constexpr size_t WS_WDN = 60 * MiB, WDN_SZ = 11 * MiB / 2;
constexpr size_t WS_WIN = 82 * MiB, WIN_SZ = 5 * MiB;
constexpr size_t WS_WOUT = 92 * MiB, WOUT_SZ = 2 * MiB;
constexpr size_t WS_H = 96 * MiB;
constexpr size_t WS_QR = 96 * MiB, WS_KR = 108 * MiB;
constexpr size_t WS_ACT = 120 * MiB;
constexpr size_t WS_Z = 120 * MiB, WS_EB = 180 * MiB, WS_VTP = 181 * MiB;
constexpr size_t WS_MIX = 186 * MiB;
constexpr size_t WS_QINP = 210 * MiB, WS_KOUTT = 222 * MiB, WS_VT = 234 * MiB, WS_YT = 246 * MiB, WS_OSC = 258 * MiB, WS_END = 270 * MiB;
constexpr int CW_BAR = 4096;
constexpr int CW_Q = 16384;
constexpr int RING_BYTES = 131072, LDSCTL_OFF = RING_BYTES, MISC_OFF = LDSCTL_OFF + 320, LDS_BYTES = 147456;
constexpr int OUT_YP = 0, OUT_YS = 8388608, OUT_CK = 12582912, OUT_CV = 14680064, OUT_ST = 16777216, OUT_TOTAL = 18874368;

typedef float f32x16 __attribute__((ext_vector_type(16)));
typedef unsigned u32x2 __attribute__((ext_vector_type(2)));
__device__ __forceinline__ float bf2f(unsigned b) { return __uint_as_float(b << 16); }
__device__ __forceinline__ float ex2(float x) { return __builtin_amdgcn_exp2f(x); }
__device__ __forceinline__ float expf_fast(float x) { return __builtin_amdgcn_exp2f(x * LOG2E); }
__device__ __forceinline__ int swap23(int s) { return (s & ~12) | ((s & 4) << 1) | ((s & 8) >> 1); }
__device__ __forceinline__ bf16x8 pack8(const float* a) { v4u w; w.x = pk2(a[0], a[1]); w.y = pk2(a[2], a[3]); w.z = pk2(a[4], a[5]); w.w = pk2(a[6], a[7]); return __builtin_bit_cast(bf16x8, w); }
__device__ __forceinline__ int krow(int reg, int h) { return (reg & 3) + 8 * (reg >> 2) + 4 * h; }

typedef const float* fptr_t;
#define KIN(i) (((const fptr_t __attribute__((address_space(4)))*)__builtin_amdgcn_kernarg_segment_ptr())[i])
struct Frame {
    LAS unsigned char* lds; volatile LAS unsigned* MISC; gu32* ctl;
    int tid, lane, wave, G;
    float* out; unsigned char* ws;
};

__device__ __forceinline__ void p0_transpose_item(const float* W, int ldw, bf16* WT, int K, int dst_row0, int src_col0, int k0, LAS float* scr, int lane) {
    float v[32];
#pragma unroll
    for (int i = 0; i < 32; ++i) { const int kk = 2 * i + (lane >> 5); v[i] = W[(size_t)(k0 + kk) * ldw + src_col0 + (lane & 31)]; }
#pragma unroll
    for (int i = 0; i < 32; ++i) { const int kk = 2 * i + (lane >> 5); scr[kk * 33 + (lane & 31)] = v[i]; }
    LDS_WAIT(); asm volatile("" ::: "memory");
    const int c = lane & 7;
#pragma unroll
    for (int j = 0; j < 4; ++j) { const int n = (lane >> 3) + 8 * j; const LAS float* s = scr + (8 * c) * 33 + n;
        v4u o; o.x = pk2(s[0 * 33], s[1 * 33]); o.y = pk2(s[2 * 33], s[3 * 33]); o.z = pk2(s[4 * 33], s[5 * 33]); o.w = pk2(s[6 * 33], s[7 * 33]);
        *(GAS v4u*)(WT + (size_t)(dst_row0 + n) * K + k0 + 8 * c) = o; }
    LDS_WAIT(); asm volatile("" ::: "memory");
}
__device__ __forceinline__ void p0_fold_item(const float* Win, bf16* WT, int n0, int k0, LAS float* scr, int lane) {
    const int comp = n0 >> 8, g = (n0 & 255) >> 6, c0 = n0 & 63;
    LAS float* tw = scr + 32 * 65; LAS float* scr2 = tw + 64;
    tw[lane] = __builtin_amdgcn_cosf((float)lane * (1.0f / 64.0f)) * 0.125f;
#pragma unroll 8
    for (int i = 0; i < 32; ++i) scr[i * 65 + lane] = Win[(size_t)(k0 + i) * 2304 + g * 64 + lane];
    LDS_WAIT(); asm volatile("" ::: "memory");
    const int kk = lane & 31, ch = lane >> 5;
    for (int ci = 0; ci < 16; ++ci) { const int cl = ch * 16 + ci, c = c0 + cl; float a = 0.f;
#pragma unroll 8
        for (int d = 0; d < 64; ++d) { const int idx = (c * d) & 63; const float t = comp ? -tw[(idx - 16) & 63] : tw[idx]; a += scr[kk * 65 + d] * t; }
        scr2[cl * 33 + kk] = a; }
    LDS_WAIT(); asm volatile("" ::: "memory");
#pragma unroll
    for (int j = 0; j < 2; ++j) { const int q = lane + 64 * j, c = q >> 2, kc = q & 3; const LAS float* s = scr2 + c * 33 + 8 * kc;
        v4u o; o.x = pk2(s[0], s[1]); o.y = pk2(s[2], s[3]); o.z = pk2(s[4], s[5]); o.w = pk2(s[6], s[7]);
        *(GAS v4u*)(WT + (size_t)(n0 + c) * 1024 + k0 + 8 * kc) = o; }
    LDS_WAIT(); asm volatile("" ::: "memory");
}
__device__ __forceinline__ void p0_mod_item(Frame& F, int it, int lane) {
    const int l = it / 576, rem = it % 576, cb = rem >> 4, ks = rem & 15;
    const int k = ks * 64 + lane;
    float sv[5];
    { const float x = KIN(6)[k]; sv[0] = x * __builtin_amdgcn_rcpf(1.0f + expf_fast(-x)); }
#pragma unroll
    for (int c = 1; c < 5; ++c) { const float x = KIN(2)[(c - 1) * 1024 + k]; sv[c] = x * __builtin_amdgcn_rcpf(1.0f + expf_fast(-x)); }
    f32x4 acc[5];
#pragma unroll
    for (int c = 0; c < 5; ++c) acc[c] = (f32x4){0.f, 0.f, 0.f, 0.f};
    const float* wp = KIN(7) + ((size_t)l * 1024 + ks * 64) * 9216 + cb * 256 + lane * 4;
#pragma unroll 8
    for (int kk = 0; kk < 64; ++kk) { const f32x4 w = *(const f32x4*)(wp + (size_t)kk * 9216);
#pragma unroll
        for (int c = 0; c < 5; ++c) { const float s = __shfl(sv[c], kk); acc[c] += w * s; } }
    float* mp = (float*)(F.ws + WS_MODP);
#pragma unroll
    for (int c = 0; c < 5; ++c) *(f32x4*)(mp + ((size_t)((ks * 2 + l) * 5 + c)) * 9216 + cb * 256 + lane * 4) = acc[c];
}
__device__ __forceinline__ void p0_twiddle_row(bf16* T, int L, int p, int lane) {
    const float sc = L == 1024 ? 0.03125f : 0.0625f, invL = 1.0f / (float)L;
    for (int col0 = lane * 8; col0 < L; col0 += 512) { float a[8];
#pragma unroll
        for (int i = 0; i < 8; ++i) { const int k = col0 + i, comp = k > L / 2, t = k - comp * (L / 2); const float x = (float)((p * t) & (L - 1)) * invL;
            a[i] = (comp ? __builtin_amdgcn_sinf(x) : __builtin_amdgcn_cosf(x)) * sc; }
        *(GAS bf16x8*)(T + (size_t)p * L + col0) = pack8(a); }
}
__device__ __forceinline__ void p0_cache_item(Frame& F, int it, int lane) {
    const int blk = it & 15, kvh = (it >> 4) & 1, bl = it >> 5;
    bf16* KC = (bf16*)(F.ws + WS_KC); bf16* VCT = (bf16*)(F.ws + WS_VCT);
    float vv[32];
#pragma unroll
    for (int i = 0; i < 32; ++i) { const size_t src = (((size_t)bl * 512 + blk * 32 + i) * 2 + kvh) * 64 + lane;
        KC[(((size_t)bl * 2 + kvh) * 512 + blk * 32 + i) * 64 + lane] = (bf16)f2bf(KIN(3)[src]); vv[i] = KIN(4)[src]; }
    float a[32];
#pragma unroll
    for (int s = 0; s < 32; ++s) a[s] = vv[swap23(s)];
    bf16* dst = VCT + (((size_t)bl * 2 + kvh) * 64 + lane) * 512 + blk * 32;
#pragma unroll
    for (int j = 0; j < 4; ++j) *(GAS bf16x8*)(dst + 8 * j) = pack8(a + 8 * j);
}
__device__ __forceinline__ void p0_prologue(Frame& F) {
    LAS float* scr = (LAS float*)(F.lds + F.wave * 16384);
    const int gw = blockIdx.x * NWAVES + F.wave, NGW = F.G * NWAVES;
    constexpr int I_GU = 16 * 176, I_DN = 44 * 32, I_WIN = 16 * 64, I_FOLD = 32 * 16, I_WOUT = 16 * 32, I_LAYER = 2 * I_GU + 2 * I_DN + I_WIN + I_FOLD + I_WOUT;
    constexpr int I_W = 2 * I_LAYER, I_MOD = 2 * 576, I_TW = 1024 + 256, I_CACHE = 256, NITEMS = I_MOD + I_W + I_TW + I_CACHE;
    for (int it = gw; it < NITEMS; it += NGW) {
        int r = it;
        if (r < I_MOD) { p0_mod_item(F, r, F.lane); continue; } r -= I_MOD;
        if (r < I_W) { const int l = r / I_LAYER; r -= l * I_LAYER;
            if (r < 2 * I_GU) { const int f = r / I_GU; r -= f * I_GU; const int kb = r / 176, nb = r % 176, n0 = 32 * nb;
                const int src = ((n0 >> 7) & 1) * FF + 128 * (n0 >> 8) + (n0 & 127);
                p0_transpose_item(KIN(f ? 14 : 12) + (size_t)l * D * NGU, NGU, (bf16*)(F.ws + WS_WGU + (size_t)(l * 2 + f) * WGU_SZ), D, n0, src, 64 * kb, scr, F.lane); continue; }
            r -= 2 * I_GU;
            if (r < 2 * I_DN) { const int f = r / I_DN; r -= f * I_DN; const int kb = r / 32, nb = r % 32;
                p0_transpose_item(KIN(f ? 15 : 13) + (size_t)l * FF * D, D, (bf16*)(F.ws + WS_WDN + (size_t)(l * 2 + f) * WDN_SZ), FF, 32 * nb, 32 * nb, 64 * kb, scr, F.lane); continue; }
            r -= 2 * I_DN;
            if (r < I_WIN) { const int kb = r / 64, nb = r % 64;
                p0_transpose_item(KIN(16) + (size_t)l * D * 2304, 2304, (bf16*)(F.ws + WS_WIN + (size_t)l * WIN_SZ), D, 512 + 32 * nb, 256 + 32 * nb, 64 * kb, scr, F.lane); continue; }
            r -= I_WIN;
            if (r < I_FOLD) { const int kb = r / 16, nb = r % 16;
                p0_fold_item(KIN(16) + (size_t)l * D * 2304, (bf16*)(F.ws + WS_WIN + (size_t)l * WIN_SZ), 32 * nb, 32 * kb, scr, F.lane); continue; }
            r -= I_FOLD;
            { const int kb = r / 32, nb = r % 32;
                p0_transpose_item(KIN(17) + (size_t)l * D * D, D, (bf16*)(F.ws + WS_WOUT + (size_t)l * WOUT_SZ), D, 32 * nb, 32 * nb, 64 * kb, scr, F.lane); continue; }
        }
        r -= I_W;
        if (r < I_TW) { if (r < 1024) p0_twiddle_row((bf16*)(F.ws + WS_T1024), 1024, r, F.lane); else p0_twiddle_row((bf16*)(F.ws + WS_T256), 256, r - 1024, F.lane); continue; }
        r -= I_TW;
        p0_cache_item(F, r, F.lane);
    }
}
__device__ __forceinline__ void p0b_modtables(Frame& F) {
    const float* mp = (const float*)(F.ws + WS_MODP); float* mt = (float*)(F.ws + WS_MODT);
    for (int idx = blockIdx.x * 512 + F.tid; idx < 2 * 3 * 5 * 1024; idx += F.G * 512) {
        const int col = idx & 1023, c = (idx >> 10) % 5, lk = idx / 5120, k = lk % 3, l = lk / 3;
        float m[3];
#pragma unroll
        for (int j = 0; j < 3; ++j) { const int comp = 3 * k + j; float s = KIN(8)[l * 9216 + comp * 1024 + col];
#pragma unroll
            for (int ks = 0; ks < 16; ++ks) s += mp[((size_t)((ks * 2 + l) * 5 + c)) * 9216 + comp * 1024 + col];
            m[j] = s; }
        const float nw = KIN(9 + k)[l * 1024 + col];
        mt[idx] = nw * (1.0f + m[1]); mt[30720 + idx] = m[0]; mt[61440 + idx] = m[2] * (k == 1 ? 1.0f : 0.5f);
    }
}
__device__ __forceinline__ const float* mod_tab(Frame& F, int which, int l, int k) { return (const float*)(F.ws + WS_MODT) + which * 30720 + (l * 3 + k) * 5120; }

__device__ __forceinline__ void norm_phase(Frame& F, const float* x0, const float* x1, const float* At, const float* St) {
    bf16* H = (bf16*)(F.ws + WS_H);
    const int gw = blockIdx.x * NWAVES + F.wave, NGW = F.G * NWAVES;
    for (int m = gw; m < M; m += NGW) {
        const float* xr = (m < MC ? x0 : x1) + (size_t)m * D; const int cond = m < MC ? 0 : 1 + ((m - MC) >> 10);
        f32x4 v[4]; float s = 0.f;
#pragma unroll
        for (int j = 0; j < 4; ++j) { v[j] = *(const f32x4*)(xr + 4 * F.lane + 256 * j); s += (v[j].x * v[j].x + v[j].y * v[j].y) + (v[j].z * v[j].z + v[j].w * v[j].w); }
#pragma unroll
        for (int o = 1; o < 64; o <<= 1) s += __shfl_xor(s, o);
        const float r = 1.0f / sqrtf(s * (1.0f / D) + 1e-6f);
#pragma unroll
        for (int j = 0; j < 4; ++j) { const f32x4 a = *(const f32x4*)(At + cond * 1024 + 4 * F.lane + 256 * j), sh = *(const f32x4*)(St + cond * 1024 + 4 * F.lane + 256 * j);
            const f32x4 h = v[j] * r * a + sh; u32x2 w; w.x = pk2(h.x, h.y); w.y = pk2(h.z, h.w);
            *(u32x2*)(H + (size_t)m * D + 4 * F.lane + 256 * j) = w; }
    }
}

struct ChunkInfo { int L, rowbase, cs, cg0, seq; bool lat; };
__device__ __forceinline__ ChunkInfo chunk_info(int chunk) {
    ChunkInfo c;
    if (chunk < 256) { c.lat = false; c.seq = chunk >> 3; c.cs = chunk & 7; c.L = 256; c.rowbase = c.seq * 256; c.cg0 = c.seq * 8; }
    else { const int cc = chunk - 256; c.lat = true; c.seq = cc >> 5; c.cs = cc & 31; c.L = 1024; c.rowbase = MC + c.seq * 1024; c.cg0 = 256 + c.seq * 32; }
    return c;
}
__device__ __forceinline__ void prep_hgrn(Frame& F, int l, const ChunkInfo& ci) {
    const bf16* Z = (const bf16*)(F.ws + WS_Z);
    const int dr = F.tid >> 8, ch = F.tid & 255;
    float lb = 0.f;
    if (l == 1) { const float a0 = KIN(18)[(0 * 2 + dr) * 256 + ch], a1 = KIN(18)[(1 * 2 + dr) * 256 + ch]; lb = 1.0f / (1.0f + expf_fast(a0 - a1)); }
    const float lbf = fmaxf(lb, 1e-30f), oml = 1.0f - lb;
    float bb[32], kv[32];
    float b = 0.f;
#pragma unroll
    for (int i = 0; i < 32; ++i) { const int tau = 32 * ci.cs + i, t = dr ? ci.L - 1 - tau : tau; const bf16* zr = Z + (size_t)(ci.rowbase + t) * ZW;
        const float zf = fmaxf(bf2f(zr[(dr ? ZC_HFB : ZC_HFF) + ch]), -60.0f);
        const float e = expf_fast(-zf), sig = __builtin_amdgcn_rcpf(1.0f + e), sneg = e * sig;
        const float f = lbf + oml * sig; b += __builtin_amdgcn_logf(f) * 0.6931471805599453f;
        bb[i] = b; kv[i] = oml * sneg; }
    const float bref = bb[15], bT = bb[31];
    bf16* QR = (bf16*)(F.ws + WS_QR); bf16* KR = (bf16*)(F.ws + WS_KR); bf16* QINP = (bf16*)(F.ws + WS_QINP);
    const int chp = (ch & ~63) | swap23(ch & 63);
#pragma unroll
    for (int i = 0; i < 32; ++i) { const int tau = 32 * ci.cs + i, t = dr ? ci.L - 1 - tau : tau;
        const float qv = bf2f(Z[(size_t)(ci.rowbase + t) * ZW + ZC_HQ + ch]) * 0.125f;
        const size_t p = ((size_t)(ci.rowbase + tau) * 2 + dr) * 256;
        QR[p + ch] = (bf16)f2bf(qv * expf_fast(fminf(bb[i] - bref, 80.f)));
        KR[p + ch] = (bf16)f2bf(kv[i] * expf_fast(fminf(bref - bb[i], 80.f)));
        QINP[p + chp] = (bf16)f2bf(qv * expf_fast(bb[i])); }
    const int cg = ci.cg0 + ci.cs;
    const size_t tb = (((size_t)cg * 2 + dr) * 256 + ch) * 32;
    bf16* KOUTT = (bf16*)(F.ws + WS_KOUTT) + tb; bf16* VT = (bf16*)(F.ws + WS_VT) + tb;
#pragma unroll
    for (int j = 0; j < 4; ++j) { float a[8];
#pragma unroll
        for (int e = 0; e < 8; ++e) { const int i = swap23(8 * j + e); a[e] = kv[i] * expf_fast(bT - bb[i]); }
        *(GAS bf16x8*)(KOUTT + 8 * j) = pack8(a); }
#pragma unroll
    for (int j = 0; j < 4; ++j) { unsigned vv[8];
#pragma unroll
        for (int e = 0; e < 8; ++e) { const int tau = 32 * ci.cs + swap23(8 * j + e), t = dr ? ci.L - 1 - tau : tau; vv[e] = Z[(size_t)(ci.rowbase + t) * ZW + ZC_HI + ch]; }
        v4u w; w.x = vv[0] | (vv[1] << 16); w.y = vv[2] | (vv[3] << 16); w.z = vv[4] | (vv[5] << 16); w.w = vv[6] | (vv[7] << 16);
        *(GAS v4u*)(VT + 8 * j) = w; }
    ((float*)(F.ws + WS_EB))[((size_t)cg * 2 + dr) * 256 + ch] = expf_fast(bT);
}
__device__ __forceinline__ void head_norm_rope(float (&x)[32], const float* nw, bool rope, int pos, float scale) {
    float ss = 0.f;
#pragma unroll
    for (int j = 0; j < 32; ++j) ss += x[j] * x[j];
    ss += __shfl_xor(ss, 1);
    const float r = 1.0f / sqrtf(ss * (1.0f / 64.0f) + 1e-6f);
#pragma unroll
    for (int j = 0; j < 32; ++j) x[j] = x[j] * r * nw[j];
    if (rope) {
#pragma unroll
        for (int j = 0; j < 16; ++j) { const float inv = ex2(-(float)j * (13.287712379549449f / 16.0f));
            const float rev = (float)pos * inv * 0.15915494309189535f; const float c = __builtin_amdgcn_cosf(rev), s = __builtin_amdgcn_sinf(rev);
            const float a = x[j], bq = x[j + 16]; x[j] = a * c - bq * s; x[j + 16] = bq * c + a * s; }
    }
#pragma unroll
    for (int j = 0; j < 32; ++j) x[j] *= scale;
}
__device__ __forceinline__ void load32(const bf16* p, float (&x)[32]) {
#pragma unroll
    for (int j = 0; j < 4; ++j) { const v4u w = *(const GAS v4u*)(p + 8 * j);
        x[8 * j + 0] = bf2f(w.x & 0xffffu); x[8 * j + 1] = bf2f(w.x >> 16); x[8 * j + 2] = bf2f(w.y & 0xffffu); x[8 * j + 3] = bf2f(w.y >> 16);
        x[8 * j + 4] = bf2f(w.z & 0xffffu); x[8 * j + 5] = bf2f(w.z >> 16); x[8 * j + 6] = bf2f(w.w & 0xffffu); x[8 * j + 7] = bf2f(w.w >> 16); }
}
__device__ __forceinline__ void store32(bf16* p, const float (&x)[32]) {
#pragma unroll
    for (int j = 0; j < 4; ++j) *(GAS bf16x8*)(p + 8 * j) = pack8(&x[8 * j]);
}
__device__ __forceinline__ void prep_misc(Frame& F, int l, const ChunkInfo& ci) {
    bf16* Z = (bf16*)(F.ws + WS_Z);
    const int row0 = ci.rowbase + 32 * ci.cs, cg = ci.cg0 + ci.cs;
    if (2 * ci.cs * 32 < ci.L) { const int comp = F.tid >> 8, ch = F.tid & 255, col = ZC_Y + F.tid; unsigned vv[32];
      const bf16* zs = Z + (size_t)ci.rowbase * ZW + col;
#pragma unroll
      for (int i = 0; i < 32; ++i) { const int t = 32 * ci.cs + i; float v;
          if (t == 0) v = comp ? bf2f(zs[(size_t)(ci.L / 2) * ZW - 256]) : bf2f(zs[0]);
          else { const float a = bf2f(zs[(size_t)t * ZW]), bq = bf2f(zs[(size_t)(ci.L - t) * ZW]); v = comp ? a - bq : a + bq; }
          vv[i] = f2bf(v); }
      bf16* YT = (bf16*)(F.ws + WS_YT) + (ci.lat ? (size_t)MC * 256 + ((size_t)ci.seq * 256 + ch) * 1024 : ((size_t)ci.seq * 256 + ch) * 256) + comp * (ci.L / 2) + 32 * ci.cs;
#pragma unroll
      for (int j = 0; j < 4; ++j) { v4u w; w.x = vv[8 * j] | (vv[8 * j + 1] << 16); w.y = vv[8 * j + 2] | (vv[8 * j + 3] << 16); w.z = vv[8 * j + 4] | (vv[8 * j + 5] << 16); w.w = vv[8 * j + 6] | (vv[8 * j + 7] << 16);
          *(GAS v4u*)(YT + 8 * j) = w; } }
    { const int i = F.tid >> 4, hh = F.tid & 15, hq = hh >> 1, half = hh & 1, t = 32 * ci.cs + i;
      bf16* p = Z + (size_t)(row0 + i) * ZW + ZC_AQ + hq * 64 + half * 32; float x[32]; load32(p, x);
      head_norm_rope(x, KIN(20) + l * 64 + half * 32, ci.lat, half ? (t & 63) : (t >> 6), QSCALE); store32(p, x); }
    if (F.tid < 128) { const int i = F.tid >> 2, hh = F.tid & 3, kvh = hh >> 1, half = hh & 1, t = 32 * ci.cs + i;
      bf16* p = Z + (size_t)(row0 + i) * ZW + ZC_AK + kvh * 64 + half * 32; float x[32]; load32(p, x);
      head_norm_rope(x, KIN(21) + l * 64 + half * 32, ci.lat, half ? (t & 63) : (t >> 6), 1.0f); store32(p, x);
      if (!ci.lat) { float* o = F.out + OUT_CK + (((size_t)ci.seq * 2 + l) * 256 + t) * 128 + kvh * 64 + half * 32;
#pragma unroll
          for (int j = 0; j < 8; ++j) *(f32x4*)(o + 4 * j) = (f32x4){x[4 * j], x[4 * j + 1], x[4 * j + 2], x[4 * j + 3]}; } }
    else if (F.tid < 256) { const int vc = F.tid - 128; unsigned vv[32];
#pragma unroll
      for (int i = 0; i < 32; ++i) vv[i] = Z[(size_t)(row0 + i) * ZW + ZC_AV + vc];
      bf16* VTP = (bf16*)(F.ws + WS_VTP) + ((size_t)cg * 128 + vc) * 32;
#pragma unroll
      for (int j = 0; j < 4; ++j) { v4u w;
          w.x = vv[swap23(8 * j + 0)] | (vv[swap23(8 * j + 1)] << 16); w.y = vv[swap23(8 * j + 2)] | (vv[swap23(8 * j + 3)] << 16);
          w.z = vv[swap23(8 * j + 4)] | (vv[swap23(8 * j + 5)] << 16); w.w = vv[swap23(8 * j + 6)] | (vv[swap23(8 * j + 7)] << 16);
          *(GAS v4u*)(VTP + 8 * j) = w; }
      if (!ci.lat) {
#pragma unroll
          for (int i = 0; i < 32; ++i) F.out[OUT_CV + (((size_t)ci.seq * 2 + l) * 256 + 32 * ci.cs + i) * 128 + vc] = bf2f(vv[i]); } }
}
__device__ __forceinline__ void prep_phase(Frame& F, int l) {
    for (int it = blockIdx.x; it < 2 * NCHUNK; it += F.G) {
        const ChunkInfo ci = chunk_info(it >> 1);
        if (it & 1) prep_misc(F, l, ci); else prep_hgrn(F, l, ci);
    }
}

#define MFMA32(a, b, c) __builtin_amdgcn_mfma_f32_32x32x16_bf16((a), (b), (c), 0, 0, 0)
__device__ __forceinline__ bf16x8 ld8(const bf16* p) { return *(const GAS bf16x8*)p; }
__device__ __forceinline__ bf16x8 cvt8(const f32x16& v, int s) { v4u w; w.x = pk2(v[8 * s], v[8 * s + 1]); w.y = pk2(v[8 * s + 2], v[8 * s + 3]); w.z = pk2(v[8 * s + 4], v[8 * s + 5]); w.w = pk2(v[8 * s + 6], v[8 * s + 7]); return __builtin_bit_cast(bf16x8, w); }
__device__ __forceinline__ f32x16 zero16() { f32x16 z; for (int i = 0; i < 16; ++i) z[i] = 0.f; return z; }

__device__ __forceinline__ void attn_unit(Frame& F, int l, bool lat, int seq, int hq, int qb) {
    const int L = lat ? 1024 : 256, rowbase = lat ? MC + seq * 1024 : seq * 256, r = F.lane & 31, h = F.lane >> 5, kvh = hq >> 2;
    const int cg0 = lat ? 256 + seq * 32 : seq * 8;
    const bf16* Z = (const bf16*)(F.ws + WS_Z);
    bf16x8 qf[4];
#pragma unroll
    for (int kk = 0; kk < 4; ++kk) qf[kk] = ld8(Z + (size_t)(rowbase + 32 * qb + r) * ZW + ZC_AQ + hq * 64 + 16 * kk + 8 * h);
    float m = KIN(22)[l * 8 + hq] * LOG2E, lsum = 1.0f;
    f32x16 ot[2]; ot[0] = zero16(); ot[1] = zero16();
    const int kb_lo = lat ? (qb - 4 < 0 ? 0 : qb - 4) : 0, kb_hi = lat ? (qb + 4 > 31 ? 31 : qb + 4) : 7;
    const int nloc = kb_hi - kb_lo + 1, ntile = nloc + (lat ? 16 : 0);
    const bf16* VTP = (const bf16*)(F.ws + WS_VTP);
    const bf16* KC = (const bf16*)(F.ws + WS_KC) + (((size_t)(seq * 2 + l) * 2 + kvh) * 512) * 64;
    const bf16* VCT = (const bf16*)(F.ws + WS_VCT) + (((size_t)(seq * 2 + l) * 2 + kvh) * 64) * 512;
    for (int ti = 0; ti < ntile; ++ti) {
        const bool loc = ti < nloc; const int kb = loc ? kb_lo + ti : ti - nloc;
        const bf16* kp = loc ? Z + (size_t)(rowbase + 32 * kb + r) * ZW + ZC_AK + kvh * 64 + 8 * h : KC + (size_t)(32 * kb + r) * 64 + 8 * h;
        const bf16* vp = loc ? VTP + ((size_t)(cg0 + kb) * 128 + kvh * 64 + r) * 32 + 8 * h : VCT + (size_t)r * 512 + 32 * kb + 8 * h;
        const size_t vstep = loc ? 32 * 32 : 32 * 512;
        bf16x8 kf[4], vf[2][2];
#pragma unroll
        for (int kk = 0; kk < 4; ++kk) kf[kk] = ld8(kp + 16 * kk);
#pragma unroll
        for (int tv = 0; tv < 2; ++tv)
#pragma unroll
            for (int s = 0; s < 2; ++s) vf[tv][s] = ld8(vp + tv * vstep + 16 * s);
        f32x16 st = zero16();
#pragma unroll
        for (int kk = 0; kk < 4; ++kk) st = MFMA32(kf[kk], qf[kk], st);
        if (lat && loc) { const int dq = 32 * qb + r - 32 * kb - 4 * h;
#pragma unroll
            for (int reg = 0; reg < 16; ++reg) { const int d = dq - ((reg & 3) + 8 * (reg >> 2)); if (d > 128 || d < -128) st[reg] = -INFINITY; } }
        float mx = st[0];
#pragma unroll
        for (int reg = 1; reg < 16; ++reg) mx = fmaxf(mx, st[reg]);
        mx = fmaxf(mx, __shfl_xor(mx, 32));
        const float mn = fmaxf(m, mx), alpha = ex2(m - mn); m = mn;
        float rs = 0.f;
#pragma unroll
        for (int reg = 0; reg < 16; ++reg) { st[reg] = ex2(st[reg] - mn); rs += st[reg]; }
        rs += __shfl_xor(rs, 32);
        lsum = lsum * alpha + rs;
#pragma unroll
        for (int reg = 0; reg < 16; ++reg) { ot[0][reg] *= alpha; ot[1][reg] *= alpha; }
        const bf16x8 p0 = cvt8(st, 0), p1 = cvt8(st, 1);
        ot[0] = MFMA32(vf[0][0], p0, ot[0]); ot[0] = MFMA32(vf[0][1], p1, ot[0]);
        ot[1] = MFMA32(vf[1][0], p0, ot[1]); ot[1] = MFMA32(vf[1][1], p1, ot[1]);
    }
    const float inv = 1.0f / lsum;
    bf16* o = (bf16*)(F.ws + WS_MIX) + (size_t)(rowbase + 32 * qb + r) * 1024 + 512 + hq * 64 + 4 * h;
#pragma unroll
    for (int tv = 0; tv < 2; ++tv)
#pragma unroll
        for (int gq = 0; gq < 4; ++gq) { u32x2 w; w.x = pk2(ot[tv][4 * gq] * inv, ot[tv][4 * gq + 1] * inv); w.y = pk2(ot[tv][4 * gq + 2] * inv, ot[tv][4 * gq + 3] * inv);
            *(GAS u32x2*)(o + 32 * tv + 8 * gq) = w; }
}

constexpr int HG_STAGE = 40 * 1024;
__device__ __forceinline__ void hgrn_unit(Frame& F, int l, bool lat, int seq, int hd) {
    const int L = lat ? 1024 : 256, rowbase = lat ? MC + seq * 1024 : seq * 256, r = F.lane & 31, h = F.lane >> 5;
    const int cg0 = lat ? 256 + seq * 32 : seq * 8, nch = L / 32;
    if (F.wave >= 4) {
        const int lw = F.wave - 4;
        const char* src[10];
#pragma unroll
        for (int i = 0; i < 10; ++i) { const int f = lw * 10 + i, dr = f / 20, q = f % 20;
            const size_t pb = ((size_t)(rowbase + r) * 2 + dr) * 256 + hd * 64 + 8 * h;
            const size_t cb = ((size_t)cg0 * 2 + dr) * 256 + hd * 64;
            const bf16* p;
            if (q < 4) p = (const bf16*)(F.ws + WS_KR) + pb + 16 * q;
            else if (q < 8) p = (const bf16*)(F.ws + WS_QR) + pb + 16 * (q - 4);
            else if (q < 12) p = (const bf16*)(F.ws + WS_QINP) + pb + 16 * (q - 8);
            else if (q < 16) p = (const bf16*)(F.ws + WS_KOUTT) + (cb + 32 * ((q - 12) >> 1) + r) * 32 + 16 * ((q - 12) & 1) + 8 * h;
            else p = (const bf16*)(F.ws + WS_VT) + (cb + 32 * ((q - 16) >> 1) + r) * 32 + 16 * ((q - 16) & 1) + 8 * h;
            src[i] = (const char*)p; }
#define HG_ISSUE(cs_) do { const unsigned sb_ = (unsigned)(((cs_) % 3) * HG_STAGE + lw * 10240); const size_t go_ = (size_t)(cs_) * 32768; \
        _Pragma("unroll") for (int i_ = 0; i_ < 10; ++i_) __builtin_amdgcn_global_load_lds((const unsigned*)(src[i_] + go_), (LAS unsigned*)(F.lds + sb_ + i_ * 1024), 16, 0, 0); } while (0)
        HG_ISSUE(0); HG_ISSUE(1);
        for (int cs = 0; cs < nch; ++cs) {
            if (cs + 1 < nch) asm volatile("s_waitcnt vmcnt(10)" ::: "memory"); else asm volatile("s_waitcnt vmcnt(0)" ::: "memory");
            __builtin_amdgcn_s_barrier(); asm volatile("" ::: "memory");
            if (cs + 2 < nch) HG_ISSUE(cs + 2);
        }
#undef HG_ISSUE
    } else {
        const int dr = F.wave >> 1, dvh = F.wave & 1;
        const float* EB = (const float*)(F.ws + WS_EB) + ((size_t)cg0 * 2 + dr) * 256 + hd * 64 + F.lane;
        bf16* OSC = (bf16*)(F.ws + WS_OSC);
        f32x16 S[2];
        if (lat) { const float* s0 = KIN(5) + ((((size_t)seq * 2 + l) * 2 + dr) * 4 + hd) * 4096;
#pragma unroll
            for (int t = 0; t < 2; ++t)
#pragma unroll
                for (int reg = 0; reg < 16; ++reg) S[t][reg] = s0[(32 * t + krow(reg, h)) * 64 + 32 * dvh + r]; }
        else { S[0] = zero16(); S[1] = zero16(); }
        float ebn = EB[0];
        for (int cs = 0; cs < nch; ++cs) {
            const float ebv = ebn; if (cs + 1 < nch) ebn = EB[(size_t)(cs + 1) * 512];
            __builtin_amdgcn_s_barrier(); asm volatile("" ::: "memory");
            const LAS unsigned char* sb = F.lds + (cs % 3) * HG_STAGE + dr * 20480 + F.lane * 16;
#define HG_FR(f_) (*(const LAS bf16x8*)(sb + (f_) * 1024))
            f32x16 a1 = zero16();
#pragma unroll
            for (int kk = 0; kk < 4; ++kk) a1 = MFMA32(HG_FR(kk), HG_FR(4 + kk), a1);
#pragma unroll
            for (int reg = 0; reg < 16; ++reg) if (krow(reg, h) > r) a1[reg] = 0.f;
            const bf16x8 vt0 = HG_FR(16 + dvh * 2), vt1 = HG_FR(17 + dvh * 2);
            f32x16 ot = zero16();
            ot = MFMA32(vt0, cvt8(a1, 0), ot); ot = MFMA32(vt1, cvt8(a1, 1), ot);
#pragma unroll
            for (int t = 0; t < 2; ++t)
#pragma unroll
                for (int s = 0; s < 2; ++s) ot = MFMA32(cvt8(S[t], s), HG_FR(8 + 2 * t + s), ot);
#pragma unroll
            for (int t = 0; t < 2; ++t) {
#pragma unroll
                for (int reg = 0; reg < 16; ++reg) S[t][reg] *= __shfl(ebv, 32 * t + krow(reg, h));
                S[t] = MFMA32(HG_FR(12 + 2 * t), vt0, S[t]); S[t] = MFMA32(HG_FR(13 + 2 * t), vt1, S[t]); }
#undef HG_FR
            const int tau = 32 * cs + r, tt = dr ? L - 1 - tau : tau;
            bf16* o = OSC + ((size_t)(rowbase + tt) * 2 + dr) * 256 + hd * 64 + 32 * dvh + 4 * h;
#pragma unroll
            for (int gq = 0; gq < 4; ++gq) { u32x2 w; w.x = pk2(ot[4 * gq], ot[4 * gq + 1]); w.y = pk2(ot[4 * gq + 2], ot[4 * gq + 3]); *(GAS u32x2*)(o + 8 * gq) = w; }
        }
        if (!lat) { float* so = F.out + OUT_ST + ((((size_t)seq * 2 + l) * 2 + dr) * 4 + hd) * 4096;
#pragma unroll
            for (int t = 0; t < 2; ++t)
#pragma unroll
                for (int reg = 0; reg < 16; ++reg) so[(32 * t + krow(reg, h)) * 64 + 32 * dvh + r] = S[t][reg]; }
    }
    VM_WAIT(); __syncthreads();
    const bf16* Z = (const bf16*)(F.ws + WS_Z); bf16* MX = (bf16*)(F.ws + WS_MIX); const bf16* OSC = (const bf16*)(F.ws + WS_OSC);
    for (int idx = F.tid; idx < L * 4; idx += 512) { const int q4 = idx & 3, t = idx >> 2, row = rowbase + t;
        float of[16], ob[16], gg[16];
        { const bf16* p = OSC + ((size_t)row * 2 + 0) * 256 + hd * 64 + 16 * q4; const v4u w0 = *(const GAS v4u*)p, w1 = *(const GAS v4u*)(p + 8);
          const unsigned ww[8] = {w0.x, w0.y, w0.z, w0.w, w1.x, w1.y, w1.z, w1.w};
#pragma unroll
          for (int j = 0; j < 8; ++j) { of[2 * j] = bf2f(ww[j] & 0xffffu); of[2 * j + 1] = bf2f(ww[j] >> 16); } }
        { const bf16* p = OSC + ((size_t)row * 2 + 1) * 256 + hd * 64 + 16 * q4; const v4u w0 = *(const GAS v4u*)p, w1 = *(const GAS v4u*)(p + 8);
          const unsigned ww[8] = {w0.x, w0.y, w0.z, w0.w, w1.x, w1.y, w1.z, w1.w};
#pragma unroll
          for (int j = 0; j < 8; ++j) { ob[2 * j] = bf2f(ww[j] & 0xffffu); ob[2 * j + 1] = bf2f(ww[j] >> 16); } }
        { const bf16* p = Z + (size_t)row * ZW + ZC_HG + hd * 64 + 16 * q4; const v4u w0 = *(const GAS v4u*)p, w1 = *(const GAS v4u*)(p + 8);
          const unsigned ww[8] = {w0.x, w0.y, w0.z, w0.w, w1.x, w1.y, w1.z, w1.w};
#pragma unroll
          for (int j = 0; j < 8; ++j) { gg[2 * j] = bf2f(ww[j] & 0xffffu); gg[2 * j + 1] = bf2f(ww[j] >> 16); } }
        float ss = 0.f;
#pragma unroll
        for (int j = 0; j < 16; ++j) { of[j] += ob[j]; ss += of[j] * of[j]; }
        ss += __shfl_xor(ss, 1); ss += __shfl_xor(ss, 2);
        const float rn = 1.0f / sqrtf(ss * (1.0f / 64.0f) + 1e-6f);
        const float* nw = KIN(19) + l * 256 + hd * 64 + 16 * q4;
        float res[16];
#pragma unroll
        for (int j = 0; j < 16; ++j) { const float g = gg[j]; res[j] = of[j] * rn * nw[j] * (g * __builtin_amdgcn_rcpf(1.0f + expf_fast(-g))); }
        bf16* o = MX + (size_t)row * 1024 + 256 + hd * 64 + 16 * q4;
        *(GAS bf16x8*)o = pack8(res); *(GAS bf16x8*)(o + 8) = pack8(res + 8);
    }
}
constexpr int MIX_ITEMS = 16 + 128 + 128 + 256;
struct OneUnit { int pm, pn; bool has;
    __device__ bool next(int i, pg8::Unit& u) const { if (i == 0 && has) { u.pm = pm; u.pn = pn; return true; } return false; }
    __device__ __forceinline__ void a_ready(const pg8::Unit&) const {}
    __device__ __forceinline__ void done(const pg8::Unit&) const {} };
__device__ __forceinline__ void mix_phase(Frame& F, int l, int qoff, int tmask = 7) {
    if (tmask & 2) { const int b = (int)blockIdx.x;
        if (b < 32) { pg8::Gemm g{(const bf16*)(F.ws + WS_T256), (const bf16*)(F.ws + WS_YT), 256, 8192, 256}; OneUnit S{0, b, true};
            pg8::EpiBf16<0> E{(bf16*)(F.ws + WS_MIX), 1024, nullptr, 256, (size_t)256 * 1024, 1.f}; pg8::gemm_phase<pg8::EpiBf16<0>, OneUnit, false, true>(F.lds, g, S, E, F.tid); }
        else if (b < 48) { const int u = b - 32; pg8::Gemm g{(const bf16*)(F.ws + WS_T1024), (const bf16*)(F.ws + WS_YT) + (size_t)MC * 256, 1024, 1024, 1024}; OneUnit S{u & 3, u >> 2, true};
            pg8::EpiBf16<0> E{(bf16*)(F.ws + WS_MIX) + (size_t)MC * 1024, 1024, nullptr, 256, (size_t)1024 * 1024, 1.f}; pg8::gemm_phase<pg8::EpiBf16<0>, OneUnit, false, true>(F.lds, g, S, E, F.tid); }
        __syncthreads(); }
    gu32* head = F.ctl + CW_Q + 64 * (l + qoff);
    for (;;) {
        if (F.tid == 0) F.MISC[16] = __hip_atomic_fetch_add(head, 1u, RLX_AGENT);
        __syncthreads();
        const int it = (int)F.MISC[16];
        __syncthreads();
        if (it >= MIX_ITEMS) break;
        int j = it;
        if (j < 16) { if (tmask & 1) hgrn_unit(F, l, true, j >> 2, j & 3); continue; } j -= 16;
        if (j < 128) { if (tmask & 1) hgrn_unit(F, l, false, j >> 2, j & 3); continue; } j -= 128;
        if (j < 128) { if (tmask & 4) attn_unit(F, l, true, j >> 5, ((j >> 4) & 1) * 4 + (F.wave & 3), (j & 15) * 2 + (F.wave >> 2)); continue; } j -= 128;
        { if (tmask & 4) attn_unit(F, l, false, j >> 3, ((j >> 2) & 1) * 4 + (F.wave & 3), (j & 3) * 2 + (F.wave >> 2)); }
    }
}

#ifndef PH
#define PH 0xffff
#endif
#ifndef PROBE
#define PROBE 0
#endif
struct Args { const float* in[23]; float* out; unsigned char* ws; };
__global__ void __launch_bounds__(NWAVES * 64, 2) fwd_kernel(Args args) {
    extern __shared__ __attribute__((aligned(16))) unsigned char lds[];
    Frame F;
    F.lds = (LAS unsigned char*)lds; F.MISC = (volatile LAS unsigned*)(F.lds + MISC_OFF);
    F.tid = threadIdx.x; F.lane = F.tid & 63; F.wave = __builtin_amdgcn_readfirstlane(F.tid >> 6); F.G = gridDim.x;
    F.out = args.out; F.ws = args.ws; F.ctl = (gu32*)(args.ws + WS_CTL);
    for (int u = F.tid; u < (LDS_BYTES - LDSCTL_OFF) / 4; u += NWAVES * 64) ((LAS unsigned*)(F.lds + LDSCTL_OFF))[u] = 0u;
    __syncthreads();
    XcdBarrier bar = xcd_barrier_post((unsigned*)(F.ctl + CW_BAR), F.MISC + 8);
#define GRID_BAR() do { xcd_barrier(bar); TID_REFRESH(); } while (0)
#define TID_REFRESH() do { int t_ = threadIdx.x; asm volatile("" : "+v"(t_)); F.tid = t_; F.lane = t_ & 63; F.wave = __builtin_amdgcn_readfirstlane(t_ >> 6); } while (0)
    bf16* H = (bf16*)(F.ws + WS_H); bf16* ACT = (bf16*)(F.ws + WS_ACT); bf16* ZB = (bf16*)(F.ws + WS_Z); bf16* MX = (bf16*)(F.ws + WS_MIX);
    float* X = F.out;

#if PH & 1
    p0_prologue(F); GRID_BAR();
#if PROBE == 2
    p0_prologue(F); GRID_BAR();
#endif
#endif
#if PH & 2
    p0b_modtables(F); GRID_BAR();
#endif
#pragma nounroll
    for (int step = 0; step < 6; ++step) {
        const int l = step / 3, part = step - 3 * l;
        if (part != 1) {
            const int f = part >> 1, k = 2 * f; const bool first = step == 0;
            const float* xs0 = first ? KIN(0) : X; const float* xs1 = first ? KIN(1) - (size_t)MC * D : X;
#if PH & 4
            norm_phase(F, xs0, xs1, mod_tab(F, 0, l, k), mod_tab(F, 1, l, k)); GRID_BAR();
#if PROBE == 3
            norm_phase(F, xs0, xs1, mod_tab(F, 0, l, k), mod_tab(F, 1, l, k)); GRID_BAR();
#endif
#endif
#if PH & 8
            { pg8::Gemm g{H, (const bf16*)(F.ws + WS_WGU + (size_t)(l * 2 + f) * WGU_SZ), M, NGU, D}; pg8::StaticOrder S; S.init(M, NGU, F.G, (int)blockIdx.x);
              pg8::EpiSwiglu E{ACT, FF}; pg8::gemm_phase<pg8::EpiSwiglu, pg8::StaticOrder, true, true>(F.lds, g, S, E, F.tid); } GRID_BAR();
#endif
#if PH & 16
            { pg8::Gemm g{ACT, (const bf16*)(F.ws + WS_WDN + (size_t)(l * 2 + f) * WDN_SZ), M, D, FF}; pg8::StaticOrder S; S.init(M, D, F.G, (int)blockIdx.x);
              pg8::EpiRes E{xs0, xs1, X, mod_tab(F, 2, l, k)}; pg8::gemm_phase<pg8::EpiRes, pg8::StaticOrder, true, true>(F.lds, g, S, E, F.tid); }
            if (step != 5) GRID_BAR();
#endif
        } else {
#if PH & 4
            norm_phase(F, X, X, mod_tab(F, 0, l, 1), mod_tab(F, 1, l, 1)); GRID_BAR();
#if PROBE == 3
            norm_phase(F, X, X, mod_tab(F, 0, l, 1), mod_tab(F, 1, l, 1)); GRID_BAR();
#endif
#endif
#if PH & 32
            { pg8::Gemm g{H, (const bf16*)(F.ws + WS_WIN + (size_t)l * WIN_SZ), M, ZW, D}; pg8::StaticOrder S; S.init(M, ZW, F.G, (int)blockIdx.x);
              pg8::EpiBf16<0> E{ZB, ZW, nullptr, 0, 0, 1.f}; pg8::gemm_phase<pg8::EpiBf16<0>, pg8::StaticOrder, true, true>(F.lds, g, S, E, F.tid); } GRID_BAR();
#endif
#if PH & 64
            prep_phase(F, l); GRID_BAR();
#endif
#if PH & 128
            mix_phase(F, l, 0); GRID_BAR();
#if PROBE == 1
            mix_phase(F, l, 2); GRID_BAR();
#endif
#if PROBE >= 11 && PROBE <= 14
            mix_phase(F, l, 2, PROBE == 11 ? 1 : PROBE == 12 ? 2 : PROBE == 13 ? 4 : 0); GRID_BAR();
#endif
#if PROBE == 5
            for (int e = 0; e < 10; ++e) GRID_BAR();
#endif
#endif
#if PH & 256
            { pg8::Gemm g{MX, (const bf16*)(F.ws + WS_WOUT + (size_t)l * WOUT_SZ), M, D, D}; pg8::StaticOrder S; S.init(M, D, F.G, (int)blockIdx.x);
              pg8::EpiRes E{X, X, X, mod_tab(F, 2, l, 1)}; pg8::gemm_phase<pg8::EpiRes, pg8::StaticOrder, true, true>(F.lds, g, S, E, F.tid); } GRID_BAR();
#endif
        }
    }
}

extern "C" void kernel_launch(void* const* d_in, const int* in_sizes, int n_in, void* d_out, int out_size, void* d_ws, size_t ws_size, hipStream_t stream) {
    static int grid = 0;
    if (grid == 0) {
        if (n_in != 23 || out_size != OUT_TOTAL || ws_size < WS_END) { fprintf(stderr, "kernel_launch: unexpected shapes (n_in %d, out %d, ws %zu)\n", n_in, out_size, ws_size); grid = -1; return; }
        int dev = 0, cus = 0;
        if (hipGetDevice(&dev) != hipSuccess || hipDeviceGetAttribute(&cus, hipDeviceAttributeMultiprocessorCount, dev) != hipSuccess) { grid = -1; return; }
        if (hipFuncSetAttribute((const void*)fwd_kernel, hipFuncAttributeMaxDynamicSharedMemorySize, LDS_BYTES) != hipSuccess) { fprintf(stderr, "kernel_launch: hipFuncSetAttribute failed\n"); grid = -1; return; }
        (void)hipGetLastError();
        grid = cus;
    }
    if (grid < 0) return;
    if (hipMemsetAsync((char*)d_ws + WS_CTL, 0, CTL_ZERO_BYTES, stream) != hipSuccess) return;
    Args a{};
    for (int i = 0; i < 23; ++i) a.in[i] = (const float*)d_in[i];
    a.out = (float*)d_out; a.ws = (unsigned char*)d_ws;
    hipLaunchKernelGGL(fwd_kernel, dim3(grid), dim3(NWAVES * 64), LDS_BYTES, stream, a);
}
```

```cpp
#include <hip/hip_runtime.h>
#include <cstdio>
#include <cstdint>
namespace pg8 {
#define PG8_LAS __attribute__((address_space(3)))
typedef unsigned short bf16_t;
typedef short bf16x8 __attribute__((ext_vector_type(8)));
typedef float f32x4 __attribute__((ext_vector_type(4)));
typedef unsigned u32x4 __attribute__((ext_vector_type(4)));
constexpr int BM = 256, BK = 64, HALF = 128, HTB = HALF * BK * 2  , STAGE_BYTES = 8 * HTB, NXCD = 8, WGM = 8;

__host__ __device__ __forceinline__ int lds_byte(int r, int c) { const int st = (r >> 4) * 2 + (c >> 5), rr = r & 15, cc = c & 31, ob = rr * 64 + cc * 2; return st * 1024 + (ob ^ (((ob >> 9) & 1) << 5)); }
__host__ __device__ __forceinline__ void stage_rc(int b, int& R, int& C) { const int st = b / 1024, sb = b % 1024, swz = sb ^ (((sb >> 9) & 1) << 5); R = (st >> 1) * 16 + swz / 64; C = (st & 1) * 32 + (swz % 64) / 2; }
__host__ __device__ __forceinline__ int perm32(int rho) { const int n = rho >> 4, i = rho & 15; return 8 * (i >> 2) + 4 * n + (i & 3); }

struct Unit { int pm, pn; };
struct Gemm { const bf16_t* A; const bf16_t* Bt; int M, N, K; };

struct StaticOrder {
    int nM, nN, nwg, G, c;
    __host__ __device__ void init(int M, int N, int G_, int c_) { nM = M / BM; nN = N / BM; nwg = nM * nN; G = G_; c = c_; }
    __host__ __device__ bool next(int i, Unit& u) const {
        const long L = (long)i * G + c; if (L >= nwg) return false;
        int wgid = (int)L; { const int q = nwg / NXCD, r = nwg % NXCD, xcd = wgid % NXCD, off = wgid / NXCD; wgid = (xcd < r ? xcd * (q + 1) : r * (q + 1) + (xcd - r) * q) + off; }
        const int nig = WGM * nN, gid = wgid / nig, fm = gid * WGM, gsz = (nM - fm) < WGM ? (nM - fm) : WGM;
        u.pm = fm + ((wgid % nig) % gsz); u.pn = (wgid % nig) / gsz; return true;
    }
    __device__ __forceinline__ void a_ready(const Unit&) const {}
    __device__ __forceinline__ void done(const Unit&) const {}
};

__device__ __forceinline__ unsigned cvt_pk_bf16(float lo, float hi) { unsigned r; asm volatile("v_cvt_pk_bf16_f32 %0, %1, %2" : "=v"(r) : "v"(lo), "v"(hi)); return r; }
typedef float f32x2 __attribute__((ext_vector_type(2)));
__device__ __forceinline__ f32x2 gelu_pk(f32x2 v) {
    const f32x2 av = __builtin_elementwise_abs(v), d = av * 0.2316418882f + 1.0f;
    f32x2 t; t.x = __builtin_amdgcn_rcpf(d.x); t.y = __builtin_amdgcn_rcpf(d.y);
    f32x2 q = t * 0.5307027145f + (-0.7265760135f); q = q * t + 0.7107068705f; q = q * t + (-0.142248368f); q = q * t + 0.127414796f; q = q * t;
    const f32x2 s = (v * v) * (-0.72134752044f);
    f32x2 e; e.x = __builtin_amdgcn_exp2f(s.x); e.y = __builtin_amdgcn_exp2f(s.y);
    const f32x2 m = v * (q * e), r = v - m;
    f32x2 o; o.x = v.x < 0.f ? m.x : r.x; o.y = v.y < 0.f ? m.y : r.y; return o;
}

template <int ACT  > struct EpiBf16 {
    static constexpr bool PERM = true, AFTER_DRAIN = false; static_assert(ACT == 0 || ACT == 1, "EpiBf16: ACT is 0 (none) or 1 (gelu_pk)");
    bf16_t* O; int ldc; const float* bias; int split_cols; size_t split_stride; float scale0;
    __device__ __forceinline__ void operator()(const f32x4 (&acc)[2][2][4][2], const Unit& u, int wr, int wc, int fr, int fq) const {
        const int row0 = u.pm * BM + wr * 64 + fr; int colt = u.pn * BM; bf16_t* base = O;
        float sc = 1.f; if (split_cols) { const int t = colt / split_cols; base += (size_t)t * split_stride; colt -= t * split_cols; if (t == 0) sc = scale0; }
        const int col0 = colt + wc * 32 + 8 * fq, bcol0 = u.pn * BM + wc * 32 + 8 * fq;
        f32x4 bv[2][2];
#pragma unroll
        for (int bj = 0; bj < 2; ++bj)
#pragma unroll
            for (int n = 0; n < 2; ++n) bv[bj][n] = bias ? *(const f32x4*)(bias + bcol0 + bj * HALF + 4 * n) : (f32x4){0.f, 0.f, 0.f, 0.f};
#pragma unroll
        for (int ai = 0; ai < 2; ++ai)
#pragma unroll
            for (int m = 0; m < 4; ++m) { bf16_t* rowp = base + (size_t)(row0 + ai * HALF + m * 16) * ldc + col0;
#pragma unroll
                for (int bj = 0; bj < 2; ++bj) { f32x4 v0 = acc[ai][bj][m][0] + bv[bj][0], v1 = acc[ai][bj][m][1] + bv[bj][1];
                    if (ACT == 1) { f32x2 a = gelu_pk((f32x2){v0[0], v0[1]}), b = gelu_pk((f32x2){v0[2], v0[3]}), c = gelu_pk((f32x2){v1[0], v1[1]}), d = gelu_pk((f32x2){v1[2], v1[3]});
                        v0 = (f32x4){a.x, a.y, b.x, b.y}; v1 = (f32x4){c.x, c.y, d.x, d.y}; }
                    v0 = v0 * sc; v1 = v1 * sc; u32x4 w; w.x = cvt_pk_bf16(v0[0], v0[1]); w.y = cvt_pk_bf16(v0[2], v0[3]); w.z = cvt_pk_bf16(v1[0], v1[1]); w.w = cvt_pk_bf16(v1[2], v1[3]);
                    *(u32x4*)(rowp + bj * HALF) = w; } }
    }
};
struct EpiSwiglu {
    static constexpr bool PERM = true, AFTER_DRAIN = false;
    bf16_t* O; int ldc;
    __device__ __forceinline__ void operator()(const f32x4 (&acc)[2][2][4][2], const Unit& u, int wr, int wc, int fr, int fq) const {
        const int row0 = u.pm * BM + wr * 64 + fr; const int col0 = u.pn * HALF + wc * 32 + 8 * fq;
#pragma unroll
        for (int ai = 0; ai < 2; ++ai)
#pragma unroll
            for (int m = 0; m < 4; ++m) { bf16_t* rowp = O + (size_t)(row0 + ai * HALF + m * 16) * ldc + col0;
                float a[8];
#pragma unroll
                for (int n = 0; n < 2; ++n)
#pragma unroll
                    for (int i = 0; i < 4; ++i) { const float g = acc[ai][0][m][n][i], uu = acc[ai][1][m][n][i];
                        const float sg = g * __builtin_amdgcn_rcpf(1.0f + __builtin_amdgcn_exp2f(-1.4426950408889634f * g)); a[n * 4 + i] = sg * uu; }
                u32x4 w; w.x = cvt_pk_bf16(a[0], a[1]); w.y = cvt_pk_bf16(a[2], a[3]); w.z = cvt_pk_bf16(a[4], a[5]); w.w = cvt_pk_bf16(a[6], a[7]);
                *(u32x4*)rowp = w; }
    }
};
struct EpiRes {
    static constexpr bool PERM = false, AFTER_DRAIN = false;
    const float* base0; const float* base1; float* out; const float* gate;
    __device__ __forceinline__ void operator()(const f32x4 (&acc)[2][2][4][2], const Unit& u, int wr, int wc, int fr, int fq) const {
        const int col0 = u.pn * BM + wc * 32 + 4 * fq; const int cond = u.pm < 32 ? 0 : 1 + ((u.pm - 32) >> 2);
        const float* base = u.pm < 32 ? base0 : base1;
        f32x4 gv[2][2];
#pragma unroll
        for (int bj = 0; bj < 2; ++bj)
#pragma unroll
            for (int n = 0; n < 2; ++n) gv[bj][n] = *(const f32x4*)(gate + cond * 1024 + col0 + bj * HALF + n * 16);
#pragma unroll
        for (int ai = 0; ai < 2; ++ai)
#pragma unroll
            for (int m = 0; m < 4; ++m) { const size_t off = (size_t)(u.pm * BM + ai * HALF + wr * 64 + m * 16 + fr) * 1024 + col0;
#pragma unroll
                for (int bj = 0; bj < 2; ++bj)
#pragma unroll
                    for (int n = 0; n < 2; ++n) { const f32x4 bs = *(const f32x4*)(base + off + bj * HALF + n * 16);
                        *(f32x4*)(out + off + bj * HALF + n * 16) = bs + gv[bj][n] * acc[ai][bj][m][n]; } }
    }
};
template <class Epi, class Sched, bool ALIGN_EPI = false, bool SP2 = false>
__device__ __forceinline__ void gemm_phase(PG8_LAS unsigned char* lds, const Gemm g, const Sched& S, const Epi& E, int tid_in) {
    const int tid = tid_in, wid = __builtin_amdgcn_readfirstlane(tid >> 6), lane = tid & 63, wr = wid >> 2, wc = wid & 3, fr = lane & 15, fq = lane >> 4;
    const int K = g.K, nt = K / BK;
    unsigned voffA[2], voffB[2];
#pragma unroll
    for (int i = 0; i < 2; ++i) { int R, C; stage_rc(tid * 16 + i * 8192, R, C); const int Rb = Epi::PERM ? ((R & ~31) + perm32(R & 31)) : R;
        voffA[i] = (unsigned)(R * K + C) * 2u; voffB[i] = (unsigned)(Rb * K + C) * 2u; }
    const size_t kstep = (size_t)(BK * 2);
    const size_t hstep = (size_t)HALF * K * 2;
    const size_t tstep = 2 * hstep;
    const unsigned ldsw = (unsigned)wid * 1024u;
    const int aoff = lds_byte(wr * 64 + fr, fq * 8), boff = lds_byte(wc * 32 + fr, fq * 8);
#define PG8_SA(b, h) (((b) * 2 + (h)) * HTB)
#define PG8_SB(b, h) ((4 + (b) * 2 + (h)) * HTB)
#define PG8_STAGE(bufoff, gbase, voff) do { _Pragma("unroll") for (int _i = 0; _i < 2; ++_i) \
        __builtin_amdgcn_global_load_lds((const unsigned*)((const char*)(gbase) + (voff)[_i]), (PG8_LAS unsigned*)(lds + (bufoff) + ldsw + _i * 8192), 16, 0, 0); } while (0)
#define PG8_LDA(dst, b, h) do { _Pragma("unroll") for (int m = 0; m < 4; ++m) _Pragma("unroll") for (int k = 0; k < 2; ++k) dst[m][k] = *(const PG8_LAS bf16x8*)(lds + PG8_SA(b, h) + aoff + m * 2048 + k * 1024); } while (0)
#define PG8_LDB(dst, b, h) do { _Pragma("unroll") for (int n = 0; n < 2; ++n) _Pragma("unroll") for (int k = 0; k < 2; ++k) dst[n][k] = *(const PG8_LAS bf16x8*)(lds + PG8_SB(b, h) + boff + n * 2048 + k * 1024); } while (0)
#define PG8_MMA(ai, bj, At, Bt) do { __builtin_amdgcn_s_setprio(1); _Pragma("unroll") for (int m = 0; m < 4; ++m) _Pragma("unroll") for (int n = 0; n < 2; ++n) _Pragma("unroll") for (int k = 0; k < 2; ++k) \
        acc[ai][bj][m][n] = __builtin_amdgcn_mfma_f32_16x16x32_bf16(Bt[n][k], At[m][k], acc[ai][bj][m][n], 0, 0, 0); __builtin_amdgcn_s_setprio(0); } while (0)
#define PG8_WAIT_V(n) asm volatile("s_waitcnt vmcnt(" #n ")" ::: "memory")
#define PG8_WAIT_L(n) asm volatile("s_waitcnt lgkmcnt(" #n ")" ::: "memory")
#define PG8_BAR __builtin_amdgcn_s_barrier()
#define PG8_SCHED __builtin_amdgcn_sched_barrier(0)
    Unit cur, nxt; int ui = 0;
    if (!S.next(0, cur)) return;
    f32x4 acc[2][2][4][2];
#pragma unroll
    for (int a = 0; a < 2; ++a)
#pragma unroll
        for (int b = 0; b < 2; ++b)
#pragma unroll
            for (int m = 0; m < 4; ++m)
#pragma unroll
                for (int n = 0; n < 2; ++n) acc[a][b][m][n] = (f32x4){0.f, 0.f, 0.f, 0.f};
    bf16x8 At[4][2], B0[2][2], B1[2][2];
    const char* cA = (const char*)g.A + (size_t)cur.pm * tstep; const char* cB = (const char*)g.Bt + (size_t)cur.pn * tstep;
    S.a_ready(cur);
    if constexpr (SP2) {
        PG8_STAGE(PG8_SB(0, 0), cB, voffB); PG8_STAGE(PG8_SB(0, 1), cB + hstep, voffB); PG8_STAGE(PG8_SA(0, 0), cA, voffA); PG8_STAGE(PG8_SA(0, 1), cA + hstep, voffA);
        if (wr == 1) PG8_BAR;
        PG8_WAIT_V(2); PG8_BAR;
        PG8_STAGE(PG8_SB(1, 0), cB + kstep, voffB); PG8_STAGE(PG8_SA(1, 0), cA + kstep, voffA); PG8_STAGE(PG8_SB(1, 1), cB + hstep + kstep, voffB);
        PG8_WAIT_V(6); PG8_BAR;
    } else {
        PG8_STAGE(PG8_SB(0, 0), cB, voffB); PG8_STAGE(PG8_SA(0, 0), cA, voffA); PG8_STAGE(PG8_SB(0, 1), cB + hstep, voffB); PG8_STAGE(PG8_SA(0, 1), cA + hstep, voffA);
        if (wr == 1) PG8_BAR;
        PG8_WAIT_V(4); PG8_BAR;
        PG8_STAGE(PG8_SB(1, 0), cB + kstep, voffB); PG8_STAGE(PG8_SA(1, 0), cA + kstep, voffA); PG8_STAGE(PG8_SB(1, 1), cB + hstep + kstep, voffB);
        PG8_WAIT_V(6); PG8_BAR;
    }
    for (;;) {
        const bool has_next = S.next(ui + 1, nxt);
        const char* nA = has_next ? (const char*)g.A + (size_t)nxt.pm * tstep : cA; const char* nB = has_next ? (const char*)g.Bt + (size_t)nxt.pn * tstep : cB;
        for (int t = 0; t < nt; t += 2) {
            const bool last = (t == nt - 2);
            const char* a1 = cA + (size_t)(t + 1) * kstep;
            const char* a2 = last ? nA : cA + (size_t)(t + 2) * kstep; const char* b2 = last ? nB : cB + (size_t)(t + 2) * kstep;
            const char* a3 = a2 + kstep; const char* b3 = b2 + kstep;
            if (last && has_next) S.a_ready(nxt);
            if constexpr (SP2) {
            PG8_LDB(B0, 0, 0); PG8_LDB(B1, 0, 1); PG8_SCHED; PG8_LDA(At, 0, 0); PG8_STAGE(PG8_SA(1, 1), a1 + hstep, voffA);
            PG8_WAIT_V(8); PG8_WAIT_L(0); PG8_BAR; PG8_MMA(0, 0, At, B0); PG8_MMA(0, 1, At, B1); PG8_BAR; PG8_SCHED;
            PG8_LDA(At, 0, 1); PG8_STAGE(PG8_SB(0, 0), b2, voffB); PG8_STAGE(PG8_SB(0, 1), b2 + hstep, voffB); PG8_STAGE(PG8_SA(0, 0), a2, voffA);
            PG8_WAIT_V(8); PG8_WAIT_L(0); PG8_BAR; PG8_MMA(1, 0, At, B0); PG8_MMA(1, 1, At, B1); PG8_BAR; PG8_SCHED;
            PG8_LDB(B0, 1, 0); PG8_LDB(B1, 1, 1); PG8_SCHED; PG8_LDA(At, 1, 0); PG8_STAGE(PG8_SA(0, 1), a2 + hstep, voffA);
            PG8_WAIT_V(8); PG8_WAIT_L(0); PG8_BAR; PG8_MMA(0, 0, At, B0); PG8_MMA(0, 1, At, B1); PG8_BAR; PG8_SCHED;
            PG8_LDA(At, 1, 1); PG8_STAGE(PG8_SB(1, 0), b3, voffB); PG8_STAGE(PG8_SB(1, 1), b3 + hstep, voffB); PG8_STAGE(PG8_SA(1, 0), a3, voffA);
            PG8_WAIT_V(8); PG8_WAIT_L(0); PG8_BAR; PG8_MMA(1, 0, At, B0); PG8_MMA(1, 1, At, B1); PG8_BAR; PG8_SCHED;
            } else {
            PG8_LDB(B0, 0, 0); PG8_SCHED; PG8_LDA(At, 0, 0); PG8_STAGE(PG8_SA(1, 1), a1 + hstep, voffA);
            PG8_WAIT_L(8); PG8_BAR; PG8_WAIT_L(0); PG8_MMA(0, 0, At, B0); PG8_BAR; PG8_SCHED;
            PG8_LDB(B1, 0, 1); PG8_STAGE(PG8_SB(0, 0), b2, voffB);
            PG8_BAR; PG8_WAIT_L(0); PG8_MMA(0, 1, At, B1); PG8_BAR;
            PG8_LDA(At, 0, 1); PG8_STAGE(PG8_SA(0, 0), a2, voffA);
            PG8_BAR; PG8_WAIT_L(0); PG8_MMA(1, 0, At, B0); PG8_BAR; PG8_SCHED;
            PG8_STAGE(PG8_SB(0, 1), b2 + hstep, voffB);
            PG8_WAIT_V(6); PG8_BAR; PG8_MMA(1, 1, At, B1); PG8_BAR;
            PG8_LDB(B0, 1, 0); PG8_SCHED; PG8_LDA(At, 1, 0); PG8_STAGE(PG8_SA(0, 1), a2 + hstep, voffA);
            PG8_WAIT_L(8); PG8_BAR; PG8_WAIT_L(0); PG8_MMA(0, 0, At, B0); PG8_BAR; PG8_SCHED;
            PG8_LDB(B1, 1, 1); PG8_STAGE(PG8_SB(1, 0), b3, voffB);
            PG8_BAR; PG8_WAIT_L(0); PG8_MMA(0, 1, At, B1); PG8_BAR;
            PG8_LDA(At, 1, 1); PG8_STAGE(PG8_SA(1, 0), a3, voffA);
            PG8_BAR; PG8_WAIT_L(0); PG8_MMA(1, 0, At, B0); PG8_BAR; PG8_SCHED;
            PG8_STAGE(PG8_SB(1, 1), b3 + hstep, voffB);
            PG8_WAIT_V(6); PG8_BAR; PG8_MMA(1, 1, At, B1); PG8_BAR;
            }
        }
        if constexpr (ALIGN_EPI) { if (wr == 0) PG8_BAR; }
        if constexpr (!Epi::AFTER_DRAIN) { E(acc, cur, wr, wc, fr, fq); S.done(cur); }
        if (!has_next) break;
#pragma unroll
        for (int a = 0; a < 2; ++a)
#pragma unroll
            for (int b = 0; b < 2; ++b)
#pragma unroll
                for (int m = 0; m < 4; ++m)
#pragma unroll
                    for (int n = 0; n < 2; ++n) acc[a][b][m][n] = (f32x4){0.f, 0.f, 0.f, 0.f};
        cur = nxt; cA = nA; cB = nB; ++ui;
        if constexpr (ALIGN_EPI) { if (wr == 1) PG8_BAR; }
    }
    PG8_WAIT_V(0);
    if constexpr (!ALIGN_EPI) { if (wr == 0) PG8_BAR; }
    PG8_BAR;
    if constexpr (Epi::AFTER_DRAIN) { E.fused(acc, cur, wr, wc, fr, fq, lds, wid, lane); S.done(cur); }
#undef PG8_SA
#undef PG8_SB
#undef PG8_STAGE
#undef PG8_LDA
#undef PG8_LDB
#undef PG8_MMA
#undef PG8_WAIT_V
#undef PG8_WAIT_L
#undef PG8_BAR
#undef PG8_SCHED
}
}
#define GAS __attribute__((address_space(1)))
#define LAS __attribute__((address_space(3)))
typedef unsigned short bf16;
typedef unsigned v4u __attribute__((ext_vector_type(4)));
typedef float f32x4 __attribute__((ext_vector_type(4)));
typedef short bf16x8 __attribute__((ext_vector_type(8)));
typedef GAS unsigned gu32;
typedef GAS unsigned long long gu64;
#define RLX_AGENT __ATOMIC_RELAXED, __HIP_MEMORY_SCOPE_AGENT
#define LDS_WAIT() asm volatile("s_waitcnt lgkmcnt(0)" ::: "memory")
#define VM_WAIT() asm volatile("s_waitcnt vmcnt(0)" ::: "memory")
__device__ __forceinline__ unsigned long long rt() { return __builtin_amdgcn_s_memrealtime(); }
__device__ __forceinline__ unsigned f2bf(float f) { unsigned u = __builtin_bit_cast(unsigned, f); return (u + 0x7fffu + ((u >> 16) & 1u)) >> 16; }
__device__ __forceinline__ unsigned pk2(float lo, float hi) { return f2bf(lo) | (f2bf(hi) << 16); }

#define XB_TMO      128
#define XB_XCNT(j)  (256  + 64 * (j))
#define XB_XSUB(j)  (1280 + 64 * (j))
#define XB_XGEN(j)  (2304 + 64 * (j))
#define XB_TOP      3328
#define XB_TOPGEN   3392
#define XCD_BAR_WORDS 3456
#define XB_SPIN_CAP (1u << 18)

__device__ __forceinline__ unsigned xb_ld(unsigned* p)              { return __hip_atomic_load(p, __ATOMIC_RELAXED, __HIP_MEMORY_SCOPE_AGENT); }
__device__ __forceinline__ unsigned xb_add(unsigned* p, unsigned v) { return __hip_atomic_fetch_add(p, v, __ATOMIC_RELAXED, __HIP_MEMORY_SCOPE_AGENT); }
__device__ __forceinline__ unsigned xb_xcc_id() { return (unsigned)__builtin_amdgcn_s_getreg((3 << 11) | 20) & 0xFu; }
#define XB_SPIN(cond, bar) do { unsigned _sp = 0; while (cond) { __builtin_amdgcn_s_sleep(1); \
    if ((++_sp & 255u) == 0u) { if (xb_ld(&(bar)[XB_TMO])) break; if (_sp > XB_SPIN_CAP) { atomicAdd(&(bar)[XB_TMO], 1u); break; } } } } while (0)

struct XcdBarrier {
    unsigned* bar; unsigned x;
    volatile LAS unsigned* st;
};

__device__ __forceinline__ XcdBarrier xcd_barrier_post(unsigned* bar, volatile LAS unsigned* st) {
    XcdBarrier b; b.bar = bar; b.x = xb_xcc_id(); b.st = st;
    if (threadIdx.x == 0) (void)xb_add(&bar[XB_XCNT(b.x)], 1u);
    return b;
}
__device__ __forceinline__ void xcd_barrier_complete(unsigned* bar, unsigned x, unsigned& nloc, unsigned& nx) {
    const unsigned G = gridDim.x * gridDim.y * gridDim.z;
    unsigned sum, cnt, mine, sp = 0u;
    for (;;) {
        sum = 0u; cnt = 0u; mine = 0u;
#pragma unroll
        for (unsigned j = 0; j < 16; ++j) { const unsigned c = xb_ld(&bar[XB_XCNT(j)]); sum += c; cnt += (c > 0u) ? 1u : 0u; mine = (j == x) ? c : mine; }
        if (sum == G) break;
        __builtin_amdgcn_s_sleep(1);
        if ((++sp & 255u) == 0u) { if (xb_ld(&bar[XB_TMO])) break; if (sp > XB_SPIN_CAP) { atomicAdd(&bar[XB_TMO], 1u); break; } }
    }
    nloc = mine > 0u ? mine : 1u; nx = cnt > 0u ? cnt : 1u;
}

__device__ __forceinline__ void xcd_barrier(const XcdBarrier& b) {
    asm volatile("s_waitcnt vmcnt(0)" ::: "memory");
    __syncthreads();
    if (threadIdx.x == 0) {
        unsigned* bar = b.bar;
        __builtin_amdgcn_s_waitcnt(0);
        unsigned nloc = b.st[0], nx = b.st[1];
        if (nloc == 0u) { xcd_barrier_complete(bar, b.x, nloc, nx); b.st[0] = nloc; b.st[1] = nx; }
        const unsigned old = xb_add(&bar[XB_XSUB(b.x)], 1u);
        const unsigned gen = old / nloc;
        if (old + 1u == (gen + 1u) * nloc) {
            __builtin_amdgcn_fence(__ATOMIC_RELEASE, "agent");
            asm volatile("s_waitcnt vmcnt(0)" ::: "memory");
            const unsigned og = xb_add(&bar[XB_TOP], 1u);
            const unsigned tg = og / nx;
            if (og + 1u == (tg + 1u) * nx) xb_add(&bar[XB_TOPGEN], 1u);
            else XB_SPIN(xb_ld(&bar[XB_TOPGEN]) == tg, bar);
            __builtin_amdgcn_fence(__ATOMIC_ACQUIRE, "agent");
            xb_add(&bar[XB_XGEN(b.x)], 1u);
            asm volatile("s_waitcnt vmcnt(0)" ::: "memory");
        } else {
            XB_SPIN(xb_ld(&bar[XB_XGEN(b.x)]) == gen, bar);
            __builtin_amdgcn_fence(__ATOMIC_ACQUIRE, "agent");
            asm volatile("s_waitcnt vmcnt(0)" ::: "memory");
        }
    }
    __syncthreads();
}

constexpr int NWAVES = 8;
constexpr int D = 1024, M = 12288, MC = 8192, FF = 2816, NGU = 5632, ZW = 2560;
constexpr int ZC_Y = 0, ZC_HQ = 512, ZC_HI = 768, ZC_HFF = 1024, ZC_HFB = 1280, ZC_HG = 1536, ZC_AQ = 1792, ZC_AK = 2304, ZC_AV = 2432;
constexpr int NCHUNK = M / 32;
constexpr float QSCALE = 0.125f * 1.4426950408889634f;
constexpr float LOG2E = 1.4426950408889634f;
constexpr size_t MiB = 1u << 20;
constexpr size_t WS_CTL = 0, CTL_ZERO_BYTES = 1 * MiB;
constexpr size_t WS_MODP = 1 * MiB;
constexpr size_t WS_MODT = 7 * MiB;
constexpr size_t WS_T1024 = 8 * MiB, WS_T256 = 12 * MiB;
constexpr size_t WS_KC = 13 * MiB, WS_VCT = 14 * MiB;
constexpr size_t WS_WGU = 16 * MiB, WGU_SZ = 11 * MiB;
constexpr size_t WS_WDN = 60 * MiB, WDN_SZ = 11 * MiB / 2;
constexpr size_t WS_WIN = 82 * MiB, WIN_SZ = 5 * MiB;
constexpr size_t WS_WOUT = 92 * MiB, WOUT_SZ = 2 * MiB;
constexpr size_t WS_H = 96 * MiB;
constexpr size_t WS_QR = 96 * MiB, WS_KR = 108 * MiB;
constexpr size_t WS_ACT = 120 * MiB;
constexpr size_t WS_Z = 120 * MiB, WS_EB = 180 * MiB, WS_VTP = 181 * MiB;
constexpr size_t WS_MIX = 186 * MiB;
constexpr size_t WS_QINP = 210 * MiB, WS_KOUTT = 222 * MiB, WS_VT = 234 * MiB, WS_YT = 246 * MiB, WS_OSC = 258 * MiB, WS_END = 270 * MiB;
constexpr int CW_BAR = 4096;
constexpr int CW_Q = 16384;
constexpr int RING_BYTES = 131072, LDSCTL_OFF = RING_BYTES, MISC_OFF = LDSCTL_OFF + 320, LDS_BYTES = 147456;
constexpr int OUT_YP = 0, OUT_YS = 8388608, OUT_CK = 12582912, OUT_CV = 14680064, OUT_ST = 16777216, OUT_TOTAL = 18874368;

typedef float f32x16 __attribute__((ext_vector_type(16)));
typedef unsigned u32x2 __attribute__((ext_vector_type(2)));
__device__ __forceinline__ float bf2f(unsigned b) { return __uint_as_float(b << 16); }
__device__ __forceinline__ float ex2(float x) { return __builtin_amdgcn_exp2f(x); }
__device__ __forceinline__ float expf_fast(float x) { return __builtin_amdgcn_exp2f(x * LOG2E); }
__device__ __forceinline__ int swap23(int s) { return (s & ~12) | ((s & 4) << 1) | ((s & 8) >> 1); }
__device__ __forceinline__ bf16x8 pack8(const float* a) { v4u w; w.x = pk2(a[0], a[1]); w.y = pk2(a[2], a[3]); w.z = pk2(a[4], a[5]); w.w = pk2(a[6], a[7]); return __builtin_bit_cast(bf16x8, w); }
__device__ __forceinline__ int krow(int reg, int h) { return (reg & 3) + 8 * (reg >> 2) + 4 * h; }

typedef const float* fptr_t;
#define KIN(i) (((const fptr_t __attribute__((address_space(4)))*)__builtin_amdgcn_kernarg_segment_ptr())[i])
struct Frame {
    LAS unsigned char* lds; volatile LAS unsigned* MISC; gu32* ctl;
    int tid, lane, wave, G;
    float* out; unsigned char* ws;
};

__device__ __forceinline__ void p0_transpose_item(const float* W, int ldw, bf16* WT, int K, int dst_row0, int src_col0, int k0, LAS float* scr, int lane) {
    float v[32];
#pragma unroll
    for (int i = 0; i < 32; ++i) { const int kk = 2 * i + (lane >> 5); v[i] = W[(size_t)(k0 + kk) * ldw + src_col0 + (lane & 31)]; }
#pragma unroll
    for (int i = 0; i < 32; ++i) { const int kk = 2 * i + (lane >> 5); scr[kk * 33 + (lane & 31)] = v[i]; }
    LDS_WAIT(); asm volatile("" ::: "memory");
    const int c = lane & 7;
#pragma unroll
    for (int j = 0; j < 4; ++j) { const int n = (lane >> 3) + 8 * j; const LAS float* s = scr + (8 * c) * 33 + n;
        v4u o; o.x = pk2(s[0 * 33], s[1 * 33]); o.y = pk2(s[2 * 33], s[3 * 33]); o.z = pk2(s[4 * 33], s[5 * 33]); o.w = pk2(s[6 * 33], s[7 * 33]);
        *(GAS v4u*)(WT + (size_t)(dst_row0 + n) * K + k0 + 8 * c) = o; }
    LDS_WAIT(); asm volatile("" ::: "memory");
}
__device__ __forceinline__ void p0_fold_item(const float* Win, bf16* WT, int n0, int k0, LAS float* scr, int lane) {
    const int comp = n0 >> 8, g = (n0 & 255) >> 6, c0 = n0 & 63;
    LAS float* tw = scr + 32 * 65; LAS float* scr2 = tw + 64;
    tw[lane] = __builtin_amdgcn_cosf((float)lane * (1.0f / 64.0f)) * 0.125f;
#pragma unroll 8
    for (int i = 0; i < 32; ++i) scr[i * 65 + lane] = Win[(size_t)(k0 + i) * 2304 + g * 64 + lane];
    LDS_WAIT(); asm volatile("" ::: "memory");
    const int kk = lane & 31, ch = lane >> 5;
    for (int ci = 0; ci < 16; ++ci) { const int cl = ch * 16 + ci, c = c0 + cl; float a = 0.f;
#pragma unroll 8
        for (int d = 0; d < 64; ++d) { const int idx = (c * d) & 63; const float t = comp ? -tw[(idx - 16) & 63] : tw[idx]; a += scr[kk * 65 + d] * t; }
        scr2[cl * 33 + kk] = a; }
    LDS_WAIT(); asm volatile("" ::: "memory");
#pragma unroll
    for (int j = 0; j < 2; ++j) { const int q = lane + 64 * j, c = q >> 2, kc = q & 3; const LAS float* s = scr2 + c * 33 + 8 * kc;
        v4u o; o.x = pk2(s[0], s[1]); o.y = pk2(s[2], s[3]); o.z = pk2(s[4], s[5]); o.w = pk2(s[6], s[7]);
        *(GAS v4u*)(WT + (size_t)(n0 + c) * 1024 + k0 + 8 * kc) = o; }
    LDS_WAIT(); asm volatile("" ::: "memory");
}
__device__ __forceinline__ void p0_mod_item(Frame& F, int it, int lane) {
    const int l = it / 576, rem = it % 576, cb = rem >> 4, ks = rem & 15;
    const int k = ks * 64 + lane;
    float sv[5];
    { const float x = KIN(6)[k]; sv[0] = x * __builtin_amdgcn_rcpf(1.0f + expf_fast(-x)); }
#pragma unroll
    for (int c = 1; c < 5; ++c) { const float x = KIN(2)[(c - 1) * 1024 + k]; sv[c] = x * __builtin_amdgcn_rcpf(1.0f + expf_fast(-x)); }
    f32x4 acc[5];
#pragma unroll
    for (int c = 0; c < 5; ++c) acc[c] = (f32x4){0.f, 0.f, 0.f, 0.f};
    const float* wp = KIN(7) + ((size_t)l * 1024 + ks * 64) * 9216 + cb * 256 + lane * 4;
#pragma unroll 8
    for (int kk = 0; kk < 64; ++kk) { const f32x4 w = *(const f32x4*)(wp + (size_t)kk * 9216);
#pragma unroll
        for (int c = 0; c < 5; ++c) { const float s = __shfl(sv[c], kk); acc[c] += w * s; } }
    float* mp = (float*)(F.ws + WS_MODP);
#pragma unroll
    for (int c = 0; c < 5; ++c) *(f32x4*)(mp + ((size_t)((ks * 2 + l) * 5 + c)) * 9216 + cb * 256 + lane * 4) = acc[c];
}
__device__ __forceinline__ void p0_twiddle_row(bf16* T, int L, int p, int lane) {
    const float sc = L == 1024 ? 0.03125f : 0.0625f, invL = 1.0f / (float)L;
    for (int col0 = lane * 8; col0 < L; col0 += 512) { float a[8];
#pragma unroll
        for (int i = 0; i < 8; ++i) { const int k = col0 + i, comp = k > L / 2, t = k - comp * (L / 2); const float x = (float)((p * t) & (L - 1)) * invL;
            a[i] = (comp ? __builtin_amdgcn_sinf(x) : __builtin_amdgcn_cosf(x)) * sc; }
        *(GAS bf16x8*)(T + (size_t)p * L + col0) = pack8(a); }
}
__device__ __forceinline__ void p0_cache_item(Frame& F, int it, int lane) {
    const int blk = it & 15, kvh = (it >> 4) & 1, bl = it >> 5;
    bf16* KC = (bf16*)(F.ws + WS_KC); bf16* VCT = (bf16*)(F.ws + WS_VCT);
    float vv[32];
#pragma unroll
    for (int i = 0; i < 32; ++i) { const size_t src = (((size_t)bl * 512 + blk * 32 + i) * 2 + kvh) * 64 + lane;
        KC[(((size_t)bl * 2 + kvh) * 512 + blk * 32 + i) * 64 + lane] = (bf16)f2bf(KIN(3)[src]); vv[i] = KIN(4)[src]; }
    float a[32];
#pragma unroll
    for (int s = 0; s < 32; ++s) a[s] = vv[swap23(s)];
    bf16* dst = VCT + (((size_t)bl * 2 + kvh) * 64 + lane) * 512 + blk * 32;
#pragma unroll
    for (int j = 0; j < 4; ++j) *(GAS bf16x8*)(dst + 8 * j) = pack8(a + 8 * j);
}
__device__ __forceinline__ void p0_tile(Frame& F, const float* W, int ldw, bf16* WT, int K, int dst0, int cA, int cB, int k0) {
    LAS float* T = (LAS float*)F.lds;
    const int seg = F.lane >> 5, c4 = (F.lane & 31) * 4;
    f32x4 v[8];
#pragma unroll
    for (int i = 0; i < 8; ++i) v[i] = *(const f32x4*)(W + (size_t)(k0 + 8 * F.wave + i) * ldw + (seg ? cB : cA) + c4);
    __syncthreads();
#pragma unroll
    for (int i = 0; i < 8; ++i) { LAS float* t = T + (8 * F.wave + i) * 257 + seg * 128 + c4; t[0] = v[i].x; t[1] = v[i].y; t[2] = v[i].z; t[3] = v[i].w; }
    __syncthreads();
    const int c = F.lane & 7;
#pragma unroll
    for (int j = 0; j < 4; ++j) { const int n = 32 * F.wave + 8 * j + (F.lane >> 3); const LAS float* t = T + (8 * c) * 257 + n;
        v4u o; o.x = pk2(t[0 * 257], t[1 * 257]); o.y = pk2(t[2 * 257], t[3 * 257]); o.z = pk2(t[4 * 257], t[5 * 257]); o.w = pk2(t[6 * 257], t[7 * 257]);
        *(GAS v4u*)(WT + (size_t)(dst0 + n) * K + k0 + 8 * c) = o; }
    __syncthreads();
}
__device__ __forceinline__ void p0_prologue(Frame& F) {
    LAS float* scr = (LAS float*)(F.lds + F.wave * 16384);
    constexpr int T_GU = 16 * 22, T_DN = 44 * 4, T_WIN = 16 * 8, T_WOUT = 16 * 4, T_LAYER = 2 * T_GU + 2 * T_DN + T_WIN + T_WOUT;
    constexpr int B_MOD = 144, B_FOLD = 128, B_TILE = 2 * T_LAYER, B_TW = 160, B_CACHE = 32, NB = B_MOD + B_FOLD + B_TILE + B_TW + B_CACHE;
    for (int it = blockIdx.x; it < NB; it += F.G) {
        int r = it;
        if (r < B_MOD) { p0_mod_item(F, r * 8 + F.wave, F.lane); continue; } r -= B_MOD;
        if (r < B_FOLD) { const int q = r * 8 + F.wave, l = q >> 9, qq = q & 511, kb = qq >> 4, nb = qq & 15;
            p0_fold_item(KIN(16) + (size_t)l * D * 2304, (bf16*)(F.ws + WS_WIN + (size_t)l * WIN_SZ), 32 * nb, 32 * kb, scr, F.lane); continue; }
        r -= B_FOLD;
        if (r < B_TILE) { const int l = r / T_LAYER; r -= l * T_LAYER;
            const float* W; bf16* WT; int ldw, K, dst0, cA, cB, k0;
            if (r < 2 * T_GU) { const int f = r / T_GU; r -= f * T_GU; const int kb = r / 22, pn = r % 22;
                W = KIN(f ? 14 : 12) + (size_t)l * D * NGU; ldw = NGU; WT = (bf16*)(F.ws + WS_WGU + (size_t)(l * 2 + f) * WGU_SZ); K = D; dst0 = 256 * pn; cA = 128 * pn; cB = FF + 128 * pn; k0 = 64 * kb; }
            else if (r < 2 * T_GU + 2 * T_DN) { r -= 2 * T_GU; const int f = r / T_DN; r -= f * T_DN; const int kb = r >> 2, nb = r & 3;
                W = KIN(f ? 15 : 13) + (size_t)l * FF * D; ldw = D; WT = (bf16*)(F.ws + WS_WDN + (size_t)(l * 2 + f) * WDN_SZ); K = FF; dst0 = 256 * nb; cA = 256 * nb; cB = cA + 128; k0 = 64 * kb; }
            else if (r < 2 * T_GU + 2 * T_DN + T_WIN) { r -= 2 * T_GU + 2 * T_DN; const int kb = r >> 3, nb = r & 7;
                W = KIN(16) + (size_t)l * D * 2304; ldw = 2304; WT = (bf16*)(F.ws + WS_WIN + (size_t)l * WIN_SZ); K = D; dst0 = 512 + 256 * nb; cA = 256 + 256 * nb; cB = cA + 128; k0 = 64 * kb; }
            else { r -= 2 * T_GU + 2 * T_DN + T_WIN; const int kb = r >> 2, nb = r & 3;
                W = KIN(17) + (size_t)l * D * D; ldw = D; WT = (bf16*)(F.ws + WS_WOUT + (size_t)l * WOUT_SZ); K = D; dst0 = 256 * nb; cA = 256 * nb; cB = cA + 128; k0 = 64 * kb; }
            p0_tile(F, W, ldw, WT, K, dst0, cA, cB, k0); continue;
        }
        r -= B_TILE;
        if (r < B_TW) { const int q = r * 8 + F.wave; if (q < 1024) p0_twiddle_row((bf16*)(F.ws + WS_T1024), 1024, q, F.lane); else p0_twiddle_row((bf16*)(F.ws + WS_T256), 256, q - 1024, F.lane); continue; }
        r -= B_TW;
        p0_cache_item(F, r * 8 + F.wave, F.lane);
    }
}
__device__ __forceinline__ void p0b_modtables(Frame& F) {
    const float* mp = (const float*)(F.ws + WS_MODP); float* mt = (float*)(F.ws + WS_MODT);
    for (int idx = blockIdx.x * 512 + F.tid; idx < 2 * 3 * 5 * 1024; idx += F.G * 512) {
        const int col = idx & 1023, c = (idx >> 10) % 5, lk = idx / 5120, k = lk % 3, l = lk / 3;
        float m[3];
#pragma unroll
        for (int j = 0; j < 3; ++j) { const int comp = 3 * k + j; float s = KIN(8)[l * 9216 + comp * 1024 + col];
#pragma unroll
            for (int ks = 0; ks < 16; ++ks) s += mp[((size_t)((ks * 2 + l) * 5 + c)) * 9216 + comp * 1024 + col];
            m[j] = s; }
        const float nw = KIN(9 + k)[l * 1024 + col];
        mt[idx] = nw * (1.0f + m[1]); mt[30720 + idx] = m[0]; mt[61440 + idx] = m[2] * (k == 1 ? 1.0f : 0.5f);
    }
}
__device__ __forceinline__ const float* mod_tab(Frame& F, int which, int l, int k) { return (const float*)(F.ws + WS_MODT) + which * 30720 + (l * 3 + k) * 5120; }

__device__ __forceinline__ void norm_phase(Frame& F, const float* x0, const float* x1, const float* At, const float* St) {
    bf16* H = (bf16*)(F.ws + WS_H);
    const int gw = blockIdx.x * NWAVES + F.wave, NGW = F.G * NWAVES;
    for (int m = gw; m < M; m += NGW) {
        const float* xr = (m < MC ? x0 : x1) + (size_t)m * D; const int cond = m < MC ? 0 : 1 + ((m - MC) >> 10);
        f32x4 v[4]; float s = 0.f;
#pragma unroll
        for (int j = 0; j < 4; ++j) { v[j] = *(const f32x4*)(xr + 4 * F.lane + 256 * j); s += (v[j].x * v[j].x + v[j].y * v[j].y) + (v[j].z * v[j].z + v[j].w * v[j].w); }
#pragma unroll
        for (int o = 1; o < 64; o <<= 1) s += __shfl_xor(s, o);
        const float r = 1.0f / sqrtf(s * (1.0f / D) + 1e-6f);
#pragma unroll
        for (int j = 0; j < 4; ++j) { const f32x4 a = *(const f32x4*)(At + cond * 1024 + 4 * F.lane + 256 * j), sh = *(const f32x4*)(St + cond * 1024 + 4 * F.lane + 256 * j);
            const f32x4 h = v[j] * r * a + sh; u32x2 w; w.x = pk2(h.x, h.y); w.y = pk2(h.z, h.w);
            *(u32x2*)(H + (size_t)m * D + 4 * F.lane + 256 * j) = w; }
    }
}

struct ChunkInfo { int L, rowbase, cs, cg0, seq; bool lat; };
__device__ __forceinline__ ChunkInfo chunk_info(int chunk) {
    ChunkInfo c;
    if (chunk < 256) { c.lat = false; c.seq = chunk >> 3; c.cs = chunk & 7; c.L = 256; c.rowbase = c.seq * 256; c.cg0 = c.seq * 8; }
    else { const int cc = chunk - 256; c.lat = true; c.seq = cc >> 5; c.cs = cc & 31; c.L = 1024; c.rowbase = MC + c.seq * 1024; c.cg0 = 256 + c.seq * 32; }
    return c;
}
__device__ __forceinline__ void prep_hgrn(Frame& F, int l, const ChunkInfo& ci) {
    const bf16* Z = (const bf16*)(F.ws + WS_Z);
    const int dr = F.tid >> 8, ch = F.tid & 255;
    float lb = 0.f;
    if (l == 1) { const float a0 = KIN(18)[(0 * 2 + dr) * 256 + ch], a1 = KIN(18)[(1 * 2 + dr) * 256 + ch]; lb = 1.0f / (1.0f + expf_fast(a0 - a1)); }
    const float lbf = fmaxf(lb, 1e-30f), oml = 1.0f - lb;
    float bb[32], kv[32];
    float b = 0.f;
#pragma unroll
    for (int i = 0; i < 32; ++i) { const int tau = 32 * ci.cs + i, t = dr ? ci.L - 1 - tau : tau; const bf16* zr = Z + (size_t)(ci.rowbase + t) * ZW;
        const float zf = fmaxf(bf2f(zr[(dr ? ZC_HFB : ZC_HFF) + ch]), -60.0f);
        const float e = expf_fast(-zf), sig = __builtin_amdgcn_rcpf(1.0f + e), sneg = e * sig;
        const float f = lbf + oml * sig; b += __builtin_amdgcn_logf(f) * 0.6931471805599453f;
        bb[i] = b; kv[i] = oml * sneg; }
    const float bref = bb[15], bT = bb[31];
    bf16* QR = (bf16*)(F.ws + WS_QR); bf16* KR = (bf16*)(F.ws + WS_KR); bf16* QINP = (bf16*)(F.ws + WS_QINP);
    const int chp = (ch & ~63) | swap23(ch & 63);
#pragma unroll
    for (int i = 0; i < 32; ++i) { const int tau = 32 * ci.cs + i, t = dr ? ci.L - 1 - tau : tau;
        const float qv = bf2f(Z[(size_t)(ci.rowbase + t) * ZW + ZC_HQ + ch]) * 0.125f;
        const size_t p = ((size_t)(ci.rowbase + tau) * 2 + dr) * 256;
        QR[p + ch] = (bf16)f2bf(qv * expf_fast(fminf(bb[i] - bref, 80.f)));
        KR[p + ch] = (bf16)f2bf(kv[i] * expf_fast(fminf(bref - bb[i], 80.f)));
        QINP[p + chp] = (bf16)f2bf(qv * expf_fast(bb[i])); }
    const int cg = ci.cg0 + ci.cs;
    const size_t tb = (((size_t)cg * 2 + dr) * 256 + ch) * 32;
    bf16* KOUTT = (bf16*)(F.ws + WS_KOUTT) + tb; bf16* VT = (bf16*)(F.ws + WS_VT) + tb;
#pragma unroll
    for (int j = 0; j < 4; ++j) { float a[8];
#pragma unroll
        for (int e = 0; e < 8; ++e) { const int i = swap23(8 * j + e); a[e] = kv[i] * expf_fast(bT - bb[i]); }
        *(GAS bf16x8*)(KOUTT + 8 * j) = pack8(a); }
#pragma unroll
    for (int j = 0; j < 4; ++j) { unsigned vv[8];
#pragma unroll
        for (int e = 0; e < 8; ++e) { const int tau = 32 * ci.cs + swap23(8 * j + e), t = dr ? ci.L - 1 - tau : tau; vv[e] = Z[(size_t)(ci.rowbase + t) * ZW + ZC_HI + ch]; }
        v4u w; w.x = vv[0] | (vv[1] << 16); w.y = vv[2] | (vv[3] << 16); w.z = vv[4] | (vv[5] << 16); w.w = vv[6] | (vv[7] << 16);
        *(GAS v4u*)(VT + 8 * j) = w; }
    ((float*)(F.ws + WS_EB))[((size_t)cg * 2 + dr) * 256 + ch] = expf_fast(bT);
}
__device__ __forceinline__ void head_norm_rope(float (&x)[32], const float* nw, bool rope, int pos, float scale) {
    float ss = 0.f;
#pragma unroll
    for (int j = 0; j < 32; ++j) ss += x[j] * x[j];
    ss += __shfl_xor(ss, 1);
    const float r = 1.0f / sqrtf(ss * (1.0f / 64.0f) + 1e-6f);
#pragma unroll
    for (int j = 0; j < 32; ++j) x[j] = x[j] * r * nw[j];
    if (rope) {
#pragma unroll
        for (int j = 0; j < 16; ++j) { const float inv = ex2(-(float)j * (13.287712379549449f / 16.0f));
            const float rev = (float)pos * inv * 0.15915494309189535f; const float c = __builtin_amdgcn_cosf(rev), s = __builtin_amdgcn_sinf(rev);
            const float a = x[j], bq = x[j + 16]; x[j] = a * c - bq * s; x[j + 16] = bq * c + a * s; }
    }
#pragma unroll
    for (int j = 0; j < 32; ++j) x[j] *= scale;
}
__device__ __forceinline__ void load32(const bf16* p, float (&x)[32]) {
#pragma unroll
    for (int j = 0; j < 4; ++j) { const v4u w = *(const GAS v4u*)(p + 8 * j);
        x[8 * j + 0] = bf2f(w.x & 0xffffu); x[8 * j + 1] = bf2f(w.x >> 16); x[8 * j + 2] = bf2f(w.y & 0xffffu); x[8 * j + 3] = bf2f(w.y >> 16);
        x[8 * j + 4] = bf2f(w.z & 0xffffu); x[8 * j + 5] = bf2f(w.z >> 16); x[8 * j + 6] = bf2f(w.w & 0xffffu); x[8 * j + 7] = bf2f(w.w >> 16); }
}
__device__ __forceinline__ void store32(bf16* p, const float (&x)[32]) {
#pragma unroll
    for (int j = 0; j < 4; ++j) *(GAS bf16x8*)(p + 8 * j) = pack8(&x[8 * j]);
}
__device__ __forceinline__ void prep_misc(Frame& F, int l, const ChunkInfo& ci) {
    bf16* Z = (bf16*)(F.ws + WS_Z);
    const int row0 = ci.rowbase + 32 * ci.cs, cg = ci.cg0 + ci.cs;
    if (2 * ci.cs * 32 < ci.L) { const int comp = F.tid >> 8, ch = F.tid & 255, col = ZC_Y + F.tid; unsigned vv[32];
      const bf16* zs = Z + (size_t)ci.rowbase * ZW + col;
#pragma unroll
      for (int i = 0; i < 32; ++i) { const int t = 32 * ci.cs + i; float v;
          if (t == 0) v = comp ? bf2f(zs[(size_t)(ci.L / 2) * ZW - 256]) : bf2f(zs[0]);
          else { const float a = bf2f(zs[(size_t)t * ZW]), bq = bf2f(zs[(size_t)(ci.L - t) * ZW]); v = comp ? a - bq : a + bq; }
          vv[i] = f2bf(v); }
      bf16* YT = (bf16*)(F.ws + WS_YT) + (ci.lat ? (size_t)MC * 256 + ((size_t)ci.seq * 256 + ch) * 1024 : ((size_t)ci.seq * 256 + ch) * 256) + comp * (ci.L / 2) + 32 * ci.cs;
#pragma unroll
      for (int j = 0; j < 4; ++j) { v4u w; w.x = vv[8 * j] | (vv[8 * j + 1] << 16); w.y = vv[8 * j + 2] | (vv[8 * j + 3] << 16); w.z = vv[8 * j + 4] | (vv[8 * j + 5] << 16); w.w = vv[8 * j + 6] | (vv[8 * j + 7] << 16);
          *(GAS v4u*)(YT + 8 * j) = w; } }
    { const int i = F.tid >> 4, hh = F.tid & 15, hq = hh >> 1, half = hh & 1, t = 32 * ci.cs + i;
      bf16* p = Z + (size_t)(row0 + i) * ZW + ZC_AQ + hq * 64 + half * 32; float x[32]; load32(p, x);
      head_norm_rope(x, KIN(20) + l * 64 + half * 32, ci.lat, half ? (t & 63) : (t >> 6), QSCALE); store32(p, x); }
    if (F.tid < 128) { const int i = F.tid >> 2, hh = F.tid & 3, kvh = hh >> 1, half = hh & 1, t = 32 * ci.cs + i;
      bf16* p = Z + (size_t)(row0 + i) * ZW + ZC_AK + kvh * 64 + half * 32; float x[32]; load32(p, x);
      head_norm_rope(x, KIN(21) + l * 64 + half * 32, ci.lat, half ? (t & 63) : (t >> 6), 1.0f); store32(p, x);
      if (!ci.lat) { float* o = F.out + OUT_CK + (((size_t)ci.seq * 2 + l) * 256 + t) * 128 + kvh * 64 + half * 32;
#pragma unroll
          for (int j = 0; j < 8; ++j) *(f32x4*)(o + 4 * j) = (f32x4){x[4 * j], x[4 * j + 1], x[4 * j + 2], x[4 * j + 3]}; } }
    else if (F.tid < 256) { const int vc = F.tid - 128; unsigned vv[32];
#pragma unroll
      for (int i = 0; i < 32; ++i) vv[i] = Z[(size_t)(row0 + i) * ZW + ZC_AV + vc];
      bf16* VTP = (bf16*)(F.ws + WS_VTP) + ((size_t)cg * 128 + vc) * 32;
#pragma unroll
      for (int j = 0; j < 4; ++j) { v4u w;
          w.x = vv[swap23(8 * j + 0)] | (vv[swap23(8 * j + 1)] << 16); w.y = vv[swap23(8 * j + 2)] | (vv[swap23(8 * j + 3)] << 16);
          w.z = vv[swap23(8 * j + 4)] | (vv[swap23(8 * j + 5)] << 16); w.w = vv[swap23(8 * j + 6)] | (vv[swap23(8 * j + 7)] << 16);
          *(GAS v4u*)(VTP + 8 * j) = w; }
      if (!ci.lat) {
#pragma unroll
          for (int i = 0; i < 32; ++i) F.out[OUT_CV + (((size_t)ci.seq * 2 + l) * 256 + 32 * ci.cs + i) * 128 + vc] = bf2f(vv[i]); } }
}
__device__ __forceinline__ void prep_phase(Frame& F, int l) {
    for (int it = blockIdx.x; it < 2 * NCHUNK; it += F.G) {
        const ChunkInfo ci = chunk_info(it >> 1);
        if (it & 1) prep_misc(F, l, ci); else prep_hgrn(F, l, ci);
    }
}

#define MFMA32(a, b, c) __builtin_amdgcn_mfma_f32_32x32x16_bf16((a), (b), (c), 0, 0, 0)
__device__ __forceinline__ bf16x8 ld8(const bf16* p) { return *(const GAS bf16x8*)p; }
__device__ __forceinline__ bf16x8 cvt8(const f32x16& v, int s) { v4u w; w.x = pk2(v[8 * s], v[8 * s + 1]); w.y = pk2(v[8 * s + 2], v[8 * s + 3]); w.z = pk2(v[8 * s + 4], v[8 * s + 5]); w.w = pk2(v[8 * s + 6], v[8 * s + 7]); return __builtin_bit_cast(bf16x8, w); }
__device__ __forceinline__ f32x16 zero16() { f32x16 z; for (int i = 0; i < 16; ++i) z[i] = 0.f; return z; }

__device__ __forceinline__ void attn_block(Frame& F, int l, bool lat, int seq, int kvh, int qp) {
    const int L = lat ? 1024 : 256, rowbase = lat ? MC + seq * 1024 : seq * 256, r = F.lane & 31, h = F.lane >> 5;
    const int cg0 = lat ? 256 + seq * 32 : seq * 8;
    const int hq = kvh * 4 + (F.wave & 3), qb = 2 * qp + (F.wave >> 2);
    const int lo = lat ? (2 * qp - 4 < 0 ? 0 : 2 * qp - 4) : 0, hi = lat ? (2 * qp + 5 > 31 ? 31 : 2 * qp + 5) : 7;
    const int nloc = hi - lo + 1, ntile = nloc + (lat ? 16 : 0), ngrp = (ntile + 7) >> 3;
    const bf16* Z = (const bf16*)(F.ws + WS_Z);
    const bf16* VTP = (const bf16*)(F.ws + WS_VTP);
    const bf16* KC = (const bf16*)(F.ws + WS_KC) + (((size_t)(seq * 2 + l) * 2 + kvh) * 512) * 64;
    const bf16* VCT = (const bf16*)(F.ws + WS_VCT) + (((size_t)(seq * 2 + l) * 2 + kvh) * 64) * 512;
#define AT_ISSUE(g_) do { const int ti_ = 8 * (g_) + F.wave; if (ti_ < ntile) { const bool loc_ = ti_ < nloc; const int kb_ = loc_ ? lo + ti_ : ti_ - nloc; \
        const bf16* kp_ = loc_ ? Z + (size_t)(rowbase + 32 * kb_ + r) * ZW + ZC_AK + kvh * 64 + 8 * h : KC + (size_t)(32 * kb_ + r) * 64 + 8 * h; \
        const bf16* vp_ = loc_ ? VTP + ((size_t)(cg0 + kb_) * 128 + kvh * 64 + r) * 32 + 8 * h : VCT + (size_t)r * 512 + 32 * kb_ + 8 * h; \
        const size_t vs_ = loc_ ? 32 * 32 : 32 * 512; const unsigned sb_ = (unsigned)((((g_) & 1) * 8 + F.wave) * 8192); \
        _Pragma("unroll") for (int kk_ = 0; kk_ < 4; ++kk_) __builtin_amdgcn_global_load_lds((const unsigned*)(kp_ + 16 * kk_), (LAS unsigned*)(F.lds + sb_ + kk_ * 1024), 16, 0, 0); \
        _Pragma("unroll") for (int e_ = 0; e_ < 4; ++e_) __builtin_amdgcn_global_load_lds((const unsigned*)(vp_ + (e_ >> 1) * vs_ + 16 * (e_ & 1)), (LAS unsigned*)(F.lds + sb_ + 4096 + e_ * 1024), 16, 0, 0); } } while (0)
    AT_ISSUE(0);
    bf16x8 qf[4];
#pragma unroll
    for (int kk = 0; kk < 4; ++kk) qf[kk] = ld8(Z + (size_t)(rowbase + 32 * qb + r) * ZW + ZC_AQ + hq * 64 + 16 * kk + 8 * h);
    float m = KIN(22)[l * 8 + hq] * LOG2E, lsum = 1.0f;
    f32x16 ot[2]; ot[0] = zero16(); ot[1] = zero16();
    for (int g = 0; g < ngrp; ++g) {
        asm volatile("s_waitcnt vmcnt(0)" ::: "memory"); __builtin_amdgcn_s_barrier(); asm volatile("" ::: "memory");
        if (g + 1 < ngrp) AT_ISSUE(g + 1);
        for (int j = 0; j < 8; ++j) { const int ti = 8 * g + j; if (ti >= ntile) break;
            const bool loc = ti < nloc; const int kb = loc ? lo + ti : ti - nloc;
            if (lat && loc && (kb < qb - 4 || kb > qb + 4)) continue;
            const LAS unsigned char* sb = F.lds + ((g & 1) * 8 + j) * 8192 + F.lane * 16;
            f32x16 st = zero16();
#pragma unroll
            for (int kk = 0; kk < 4; ++kk) st = MFMA32(*(const LAS bf16x8*)(sb + kk * 1024), qf[kk], st);
            if (lat && loc) { const int dq = 32 * qb + r - 32 * kb - 4 * h;
#pragma unroll
                for (int reg = 0; reg < 16; ++reg) { const int d = dq - ((reg & 3) + 8 * (reg >> 2)); if (d > 128 || d < -128) st[reg] = -INFINITY; } }
            float mx = st[0];
#pragma unroll
            for (int reg = 1; reg < 16; ++reg) mx = fmaxf(mx, st[reg]);
            mx = fmaxf(mx, __shfl_xor(mx, 32));
            const float mn = fmaxf(m, mx), alpha = ex2(m - mn); m = mn;
            float rs = 0.f;
#pragma unroll
            for (int reg = 0; reg < 16; ++reg) { st[reg] = ex2(st[reg] - mn); rs += st[reg]; }
            rs += __shfl_xor(rs, 32);
            lsum = lsum * alpha + rs;
#pragma unroll
            for (int reg = 0; reg < 16; ++reg) { ot[0][reg] *= alpha; ot[1][reg] *= alpha; }
            const bf16x8 p0 = cvt8(st, 0), p1 = cvt8(st, 1);
            ot[0] = MFMA32(*(const LAS bf16x8*)(sb + 4096), p0, ot[0]); ot[0] = MFMA32(*(const LAS bf16x8*)(sb + 5120), p1, ot[0]);
            ot[1] = MFMA32(*(const LAS bf16x8*)(sb + 6144), p0, ot[1]); ot[1] = MFMA32(*(const LAS bf16x8*)(sb + 7168), p1, ot[1]);
        }
    }
#undef AT_ISSUE
    const float inv = 1.0f / lsum;
    bf16* o = (bf16*)(F.ws + WS_MIX) + (size_t)(rowbase + 32 * qb + r) * 1024 + 512 + hq * 64 + 4 * h;
#pragma unroll
    for (int tv = 0; tv < 2; ++tv)
#pragma unroll
        for (int gq = 0; gq < 4; ++gq) { u32x2 w; w.x = pk2(ot[tv][4 * gq] * inv, ot[tv][4 * gq + 1] * inv); w.y = pk2(ot[tv][4 * gq + 2] * inv, ot[tv][4 * gq + 3] * inv);
            *(GAS u32x2*)(o + 32 * tv + 8 * gq) = w; }
}

constexpr int HG_STAGE = 40 * 1024;
__device__ __forceinline__ void hgrn_unit(Frame& F, int l, bool lat, int seq, int hd) {
    const int L = lat ? 1024 : 256, rowbase = lat ? MC + seq * 1024 : seq * 256, r = F.lane & 31, h = F.lane >> 5;
    const int cg0 = lat ? 256 + seq * 32 : seq * 8, nch = L / 32;
    if (F.wave >= 4) {
        const int lw = F.wave - 4;
        const char* src[10];
#pragma unroll
        for (int i = 0; i < 10; ++i) { const int f = lw * 10 + i, dr = f / 20, q = f % 20;
            const size_t pb = ((size_t)(rowbase + r) * 2 + dr) * 256 + hd * 64 + 8 * h;
            const size_t cb = ((size_t)cg0 * 2 + dr) * 256 + hd * 64;
            const bf16* p;
            if (q < 4) p = (const bf16*)(F.ws + WS_KR) + pb + 16 * q;
            else if (q < 8) p = (const bf16*)(F.ws + WS_QR) + pb + 16 * (q - 4);
            else if (q < 12) p = (const bf16*)(F.ws + WS_QINP) + pb + 16 * (q - 8);
            else if (q < 16) p = (const bf16*)(F.ws + WS_KOUTT) + (cb + 32 * ((q - 12) >> 1) + r) * 32 + 16 * ((q - 12) & 1) + 8 * h;
            else p = (const bf16*)(F.ws + WS_VT) + (cb + 32 * ((q - 16) >> 1) + r) * 32 + 16 * ((q - 16) & 1) + 8 * h;
            src[i] = (const char*)p; }
#define HG_ISSUE(cs_) do { const unsigned sb_ = (unsigned)(((cs_) % 3) * HG_STAGE + lw * 10240); const size_t go_ = (size_t)(cs_) * 32768; \
        _Pragma("unroll") for (int i_ = 0; i_ < 10; ++i_) __builtin_amdgcn_global_load_lds((const unsigned*)(src[i_] + go_), (LAS unsigned*)(F.lds + sb_ + i_ * 1024), 16, 0, 0); } while (0)
        HG_ISSUE(0); HG_ISSUE(1);
        for (int cs = 0; cs < nch; ++cs) {
            if (cs + 1 < nch) asm volatile("s_waitcnt vmcnt(10)" ::: "memory"); else asm volatile("s_waitcnt vmcnt(0)" ::: "memory");
            __builtin_amdgcn_s_barrier(); asm volatile("" ::: "memory");
            if (cs + 2 < nch) HG_ISSUE(cs + 2);
        }
#undef HG_ISSUE
    } else {
        const int dr = F.wave >> 1, dvh = F.wave & 1;
        const float* EB = (const float*)(F.ws + WS_EB) + ((size_t)cg0 * 2 + dr) * 256 + hd * 64 + F.lane;
        bf16* OSC = (bf16*)(F.ws + WS_OSC);
        f32x16 S[2];
        if (lat) { const float* s0 = KIN(5) + ((((size_t)seq * 2 + l) * 2 + dr) * 4 + hd) * 4096;
#pragma unroll
            for (int t = 0; t < 2; ++t)
#pragma unroll
                for (int reg = 0; reg < 16; ++reg) S[t][reg] = s0[(32 * t + krow(reg, h)) * 64 + 32 * dvh + r]; }
        else { S[0] = zero16(); S[1] = zero16(); }
        float ebn = EB[0];
        for (int cs = 0; cs < nch; ++cs) {
            const float ebv = ebn; if (cs + 1 < nch) ebn = EB[(size_t)(cs + 1) * 512];
            __builtin_amdgcn_s_barrier(); asm volatile("" ::: "memory");
            const LAS unsigned char* sb = F.lds + (cs % 3) * HG_STAGE + dr * 20480 + F.lane * 16;
#define HG_FR(f_) (*(const LAS bf16x8*)(sb + (f_) * 1024))
            f32x16 a1 = zero16();
#pragma unroll
            for (int kk = 0; kk < 4; ++kk) a1 = MFMA32(HG_FR(kk), HG_FR(4 + kk), a1);
#pragma unroll
            for (int reg = 0; reg < 16; ++reg) if (krow(reg, h) > r) a1[reg] = 0.f;
            const bf16x8 vt0 = HG_FR(16 + dvh * 2), vt1 = HG_FR(17 + dvh * 2);
            f32x16 ot = zero16();
            ot = MFMA32(vt0, cvt8(a1, 0), ot); ot = MFMA32(vt1, cvt8(a1, 1), ot);
#pragma unroll
            for (int t = 0; t < 2; ++t)
#pragma unroll
                for (int s = 0; s < 2; ++s) ot = MFMA32(cvt8(S[t], s), HG_FR(8 + 2 * t + s), ot);
#pragma unroll
            for (int t = 0; t < 2; ++t) {
#pragma unroll
                for (int reg = 0; reg < 16; ++reg) S[t][reg] *= __shfl(ebv, 32 * t + krow(reg, h));
                S[t] = MFMA32(HG_FR(12 + 2 * t), vt0, S[t]); S[t] = MFMA32(HG_FR(13 + 2 * t), vt1, S[t]); }
#undef HG_FR
            const int tau = 32 * cs + r, tt = dr ? L - 1 - tau : tau;
            bf16* o = OSC + ((size_t)(rowbase + tt) * 2 + dr) * 256 + hd * 64 + 32 * dvh + 4 * h;
#pragma unroll
            for (int gq = 0; gq < 4; ++gq) { u32x2 w; w.x = pk2(ot[4 * gq], ot[4 * gq + 1]); w.y = pk2(ot[4 * gq + 2], ot[4 * gq + 3]); *(GAS u32x2*)(o + 8 * gq) = w; }
        }
        if (!lat) { float* so = F.out + OUT_ST + ((((size_t)seq * 2 + l) * 2 + dr) * 4 + hd) * 4096;
#pragma unroll
            for (int t = 0; t < 2; ++t)
#pragma unroll
                for (int reg = 0; reg < 16; ++reg) so[(32 * t + krow(reg, h)) * 64 + 32 * dvh + r] = S[t][reg]; }
    }
    VM_WAIT(); __syncthreads();
    const bf16* Z = (const bf16*)(F.ws + WS_Z); bf16* MX = (bf16*)(F.ws + WS_MIX); const bf16* OSC = (const bf16*)(F.ws + WS_OSC);
    for (int idx = F.tid; idx < L * 4; idx += 512) { const int q4 = idx & 3, t = idx >> 2, row = rowbase + t;
        float of[16], ob[16], gg[16];
        { const bf16* p = OSC + ((size_t)row * 2 + 0) * 256 + hd * 64 + 16 * q4; const v4u w0 = *(const GAS v4u*)p, w1 = *(const GAS v4u*)(p + 8);
          const unsigned ww[8] = {w0.x, w0.y, w0.z, w0.w, w1.x, w1.y, w1.z, w1.w};
#pragma unroll
          for (int j = 0; j < 8; ++j) { of[2 * j] = bf2f(ww[j] & 0xffffu); of[2 * j + 1] = bf2f(ww[j] >> 16); } }
        { const bf16* p = OSC + ((size_t)row * 2 + 1) * 256 + hd * 64 + 16 * q4; const v4u w0 = *(const GAS v4u*)p, w1 = *(const GAS v4u*)(p + 8);
          const unsigned ww[8] = {w0.x, w0.y, w0.z, w0.w, w1.x, w1.y, w1.z, w1.w};
#pragma unroll
          for (int j = 0; j < 8; ++j) { ob[2 * j] = bf2f(ww[j] & 0xffffu); ob[2 * j + 1] = bf2f(ww[j] >> 16); } }
        { const bf16* p = Z + (size_t)row * ZW + ZC_HG + hd * 64 + 16 * q4; const v4u w0 = *(const GAS v4u*)p, w1 = *(const GAS v4u*)(p + 8);
          const unsigned ww[8] = {w0.x, w0.y, w0.z, w0.w, w1.x, w1.y, w1.z, w1.w};
#pragma unroll
          for (int j = 0; j < 8; ++j) { gg[2 * j] = bf2f(ww[j] & 0xffffu); gg[2 * j + 1] = bf2f(ww[j] >> 16); } }
        float ss = 0.f;
#pragma unroll
        for (int j = 0; j < 16; ++j) { of[j] += ob[j]; ss += of[j] * of[j]; }
        ss += __shfl_xor(ss, 1); ss += __shfl_xor(ss, 2);
        const float rn = 1.0f / sqrtf(ss * (1.0f / 64.0f) + 1e-6f);
        const float* nw = KIN(19) + l * 256 + hd * 64 + 16 * q4;
        float res[16];
#pragma unroll
        for (int j = 0; j < 16; ++j) { const float g = gg[j]; res[j] = of[j] * rn * nw[j] * (g * __builtin_amdgcn_rcpf(1.0f + expf_fast(-g))); }
        bf16* o = MX + (size_t)row * 1024 + 256 + hd * 64 + 16 * q4;
        *(GAS bf16x8*)o = pack8(res); *(GAS bf16x8*)(o + 8) = pack8(res + 8);
    }
}
constexpr int MIX_ITEMS = 16 + 128 + 128 + 256;
struct OneUnit { int pm, pn; bool has;
    __device__ bool next(int i, pg8::Unit& u) const { if (i == 0 && has) { u.pm = pm; u.pn = pn; return true; } return false; }
    __device__ __forceinline__ void a_ready(const pg8::Unit&) const {}
    __device__ __forceinline__ void done(const pg8::Unit&) const {} };
__device__ __forceinline__ void mix_phase(Frame& F, int l, int qoff, int tmask = 7) {
    if (tmask & 2) { const int b = (int)blockIdx.x;
        if (b < 32) { pg8::Gemm g{(const bf16*)(F.ws + WS_T256), (const bf16*)(F.ws + WS_YT), 256, 8192, 256}; OneUnit S{0, b, true};
            pg8::EpiBf16<0> E{(bf16*)(F.ws + WS_MIX), 1024, nullptr, 256, (size_t)256 * 1024, 1.f}; pg8::gemm_phase<pg8::EpiBf16<0>, OneUnit, false, true>(F.lds, g, S, E, F.tid); }
        else if (b < 48) { const int u = b - 32; pg8::Gemm g{(const bf16*)(F.ws + WS_T1024), (const bf16*)(F.ws + WS_YT) + (size_t)MC * 256, 1024, 1024, 1024}; OneUnit S{u & 3, u >> 2, true};
            pg8::EpiBf16<0> E{(bf16*)(F.ws + WS_MIX) + (size_t)MC * 1024, 1024, nullptr, 256, (size_t)1024 * 1024, 1.f}; pg8::gemm_phase<pg8::EpiBf16<0>, OneUnit, false, true>(F.lds, g, S, E, F.tid); }
        __syncthreads(); }
    gu32* head = F.ctl + CW_Q + 64 * (l + qoff);
    for (;;) {
        if (F.tid == 0) F.MISC[16] = __hip_atomic_fetch_add(head, 1u, RLX_AGENT);
        __syncthreads();
        const int it = (int)F.MISC[16];
        __syncthreads();
        if (it >= MIX_ITEMS) break;
        int j = it;
        if (j < 16) { if (tmask & 1) hgrn_unit(F, l, true, j >> 2, j & 3); continue; } j -= 16;
        if (j < 128) { if (tmask & 1) hgrn_unit(F, l, false, j >> 2, j & 3); continue; } j -= 128;
        if (j < 128) { if (tmask & 4) attn_block(F, l, true, j >> 5, (j >> 4) & 1, j & 15); continue; } j -= 128;
        { if (tmask & 4) attn_block(F, l, false, j >> 3, (j >> 2) & 1, j & 3); }
    }
}

#ifndef PH
#define PH 0xffff
#endif
#ifndef PROBE
#define PROBE 0
#endif
struct Args { const float* in[23]; float* out; unsigned char* ws; };
__global__ void __launch_bounds__(NWAVES * 64, 2) fwd_kernel(Args args) {
    extern __shared__ __attribute__((aligned(16))) unsigned char lds[];
    Frame F;
    F.lds = (LAS unsigned char*)lds; F.MISC = (volatile LAS unsigned*)(F.lds + MISC_OFF);
    F.tid = threadIdx.x; F.lane = F.tid & 63; F.wave = __builtin_amdgcn_readfirstlane(F.tid >> 6); F.G = gridDim.x;
    F.out = args.out; F.ws = args.ws; F.ctl = (gu32*)(args.ws + WS_CTL);
    for (int u = F.tid; u < (LDS_BYTES - LDSCTL_OFF) / 4; u += NWAVES * 64) ((LAS unsigned*)(F.lds + LDSCTL_OFF))[u] = 0u;
    __syncthreads();
    XcdBarrier bar = xcd_barrier_post((unsigned*)(F.ctl + CW_BAR), F.MISC + 8);
#define GRID_BAR() do { xcd_barrier(bar); TID_REFRESH(); } while (0)
#define TID_REFRESH() do { int t_ = threadIdx.x; asm volatile("" : "+v"(t_)); F.tid = t_; F.lane = t_ & 63; F.wave = __builtin_amdgcn_readfirstlane(t_ >> 6); unsigned char* w_ = F.ws; asm volatile("" : "+s"(w_)); F.ws = w_; float* o_ = F.out; asm volatile("" : "+s"(o_)); F.out = o_; F.ctl = (gu32*)(w_ + WS_CTL); } while (0)
    bf16* H = (bf16*)(F.ws + WS_H); bf16* ACT = (bf16*)(F.ws + WS_ACT); bf16* ZB = (bf16*)(F.ws + WS_Z); bf16* MX = (bf16*)(F.ws + WS_MIX);
    float* X = F.out;

#if PH & 1
    p0_prologue(F); GRID_BAR();
#if PROBE == 2
    p0_prologue(F); GRID_BAR();
#endif
#endif
#if PH & 2
    p0b_modtables(F); GRID_BAR();
#endif
#pragma nounroll
    for (int step = 0; step < 6; ++step) {
        const int l = step / 3, part = step - 3 * l;
        if (part != 1) {
            const int f = part >> 1, k = 2 * f; const bool first = step == 0;
            const float* xs0 = first ? KIN(0) : X; const float* xs1 = first ? KIN(1) - (size_t)MC * D : X;
#if PH & 4
            norm_phase(F, xs0, xs1, mod_tab(F, 0, l, k), mod_tab(F, 1, l, k)); GRID_BAR();
#if PROBE == 3
            norm_phase(F, xs0, xs1, mod_tab(F, 0, l, k), mod_tab(F, 1, l, k)); GRID_BAR();
#endif
#endif
#if PH & 8
            { pg8::Gemm g{H, (const bf16*)(F.ws + WS_WGU + (size_t)(l * 2 + f) * WGU_SZ), M, NGU, D}; pg8::StaticOrder S; S.init(M, NGU, F.G, (int)blockIdx.x);
              pg8::EpiSwiglu E{ACT, FF}; pg8::gemm_phase<pg8::EpiSwiglu, pg8::StaticOrder, true, true>(F.lds, g, S, E, F.tid); } GRID_BAR();
#endif
#if PH & 16
            { pg8::Gemm g{ACT, (const bf16*)(F.ws + WS_WDN + (size_t)(l * 2 + f) * WDN_SZ), M, D, FF}; pg8::StaticOrder S; S.init(M, D, F.G, (int)blockIdx.x);
              pg8::EpiRes E{xs0, xs1, X, mod_tab(F, 2, l, k)}; pg8::gemm_phase<pg8::EpiRes, pg8::StaticOrder, true, true>(F.lds, g, S, E, F.tid); }
            if (step != 5) GRID_BAR();
#endif
        } else {
#if PH & 4
            norm_phase(F, X, X, mod_tab(F, 0, l, 1), mod_tab(F, 1, l, 1)); GRID_BAR();
#if PROBE == 3
            norm_phase(F, X, X, mod_tab(F, 0, l, 1), mod_tab(F, 1, l, 1)); GRID_BAR();
#endif
#endif
#if PH & 32
            { pg8::Gemm g{H, (const bf16*)(F.ws + WS_WIN + (size_t)l * WIN_SZ), M, ZW, D}; pg8::StaticOrder S; S.init(M, ZW, F.G, (int)blockIdx.x);
              pg8::EpiBf16<0> E{ZB, ZW, nullptr, 0, 0, 1.f}; pg8::gemm_phase<pg8::EpiBf16<0>, pg8::StaticOrder, true, true>(F.lds, g, S, E, F.tid); } GRID_BAR();
#endif
#if PH & 64
            prep_phase(F, l); GRID_BAR();
#endif
#if PH & 128
            mix_phase(F, l, 0); GRID_BAR();
#if PROBE == 1
            mix_phase(F, l, 2); GRID_BAR();
#endif
#if PROBE >= 11 && PROBE <= 14
            mix_phase(F, l, 2, PROBE == 11 ? 1 : PROBE == 12 ? 2 : PROBE == 13 ? 4 : 0); GRID_BAR();
#endif
#if PROBE == 5
            for (int e = 0; e < 10; ++e) GRID_BAR();
#endif
#endif
#if PH & 256
            { pg8::Gemm g{MX, (const bf16*)(F.ws + WS_WOUT + (size_t)l * WOUT_SZ), M, D, D}; pg8::StaticOrder S; S.init(M, D, F.G, (int)blockIdx.x);
              pg8::EpiRes E{X, X, X, mod_tab(F, 2, l, 1)}; pg8::gemm_phase<pg8::EpiRes, pg8::StaticOrder, true, true>(F.lds, g, S, E, F.tid); } GRID_BAR();
#endif
        }
    }
}

extern "C" void kernel_launch(void* const* d_in, const int* in_sizes, int n_in, void* d_out, int out_size, void* d_ws, size_t ws_size, hipStream_t stream) {
    static int grid = 0;
    if (grid == 0) {
        if (n_in != 23 || out_size != OUT_TOTAL || ws_size < WS_END) { fprintf(stderr, "kernel_launch: unexpected shapes (n_in %d, out %d, ws %zu)\n", n_in, out_size, ws_size); grid = -1; return; }
        int dev = 0, cus = 0;
        if (hipGetDevice(&dev) != hipSuccess || hipDeviceGetAttribute(&cus, hipDeviceAttributeMultiprocessorCount, dev) != hipSuccess) { grid = -1; return; }
        if (hipFuncSetAttribute((const void*)fwd_kernel, hipFuncAttributeMaxDynamicSharedMemorySize, LDS_BYTES) != hipSuccess) { fprintf(stderr, "kernel_launch: hipFuncSetAttribute failed\n"); grid = -1; return; }
        (void)hipGetLastError();
        grid = cus;
    }
    if (grid < 0) return;
    if (hipMemsetAsync((char*)d_ws + WS_CTL, 0, CTL_ZERO_BYTES, stream) != hipSuccess) return;
    Args a{};
    for (int i = 0; i < 23; ++i) a.in[i] = (const float*)d_in[i];
    a.out = (float*)d_out; a.ws = (unsigned char*)d_ws;
    hipLaunchKernelGGL(fwd_kernel, dim3(grid), dim3(NWAVES * 64), LDS_BYTES, stream, a);
}
```
